# Optimizing an MI355X kernel written in HIP

```python
import functools
import jax, jax.numpy as jnp
from jax import lax
import numpy as np

D_MODEL = 1024
BATCH = 2
SEQ = 8192
DEPTH = 4
DEC_BATCH = 4
DEC_SEQ = 8192
PAST_LEN = 128

BRANCH_WIDTH = 512
N_BRANCH = 3
A_HEADS = 4
A_HEAD_K = 128
A_HEAD_V = BRANCH_WIDTH // A_HEADS
A_KEY = A_HEADS * A_HEAD_K
A_VAL = BRANCH_WIDTH
B_HEADS = 4
B_HEAD_V = BRANCH_WIDTH // B_HEADS
B_HEAD_K = B_HEAD_V // 2
B_KEY = B_HEADS * B_HEAD_K
B_VAL = BRANCH_WIDTH
GLA_RANK = 16
GLA_NORMALIZER = 16.0
C_WIDTH = BRANCH_WIDTH
C_BLOCKS = 8
C_BLOCK = C_WIDTH // C_BLOCKS
C_CONV = 4
RG_C = 8.0
D_FF = 2816
FFN_CONV = 3
CHUNK = 16
EPS = 1e-6

IN_SPLITS = (A_KEY, A_KEY, A_KEY, A_VAL, A_VAL,
             B_KEY, B_KEY, B_VAL, B_VAL, GLA_RANK, GLA_RANK,
             C_WIDTH, C_WIDTH,
             D_MODEL, D_MODEL, D_MODEL)
N_IN = sum(IN_SPLITS)

kernel_name = 'hybrid_hgrn2_gla_rglru_encoder'


def rms_norm(x, w):
    xf = x.astype(jnp.float32)
    y = xf * lax.rsqrt(jnp.mean(xf * xf, axis=-1, keepdims=True) + EPS)
    return (y * w.astype(jnp.float32)).astype(x.dtype)


def dw_conv(x, w, b, left):
    K = w.shape[0]
    T = x.shape[1]
    xp = jnp.pad(x, ((0, 0), (left, K - 1 - left), (0, 0)))
    out = b
    for j in range(K):
        out = out + xp[:, j:j + T] * w[j]
    return out


def gla_chunk(q, k, v, log_g):
    B, T, H, dk = q.shape
    n = T // CHUNK

    def blk(t):
        return t.astype(jnp.float32).reshape(B, n, CHUNK, H, t.shape[-1])

    q, k, v, log_g = blk(q) * (dk ** -0.5), blk(k), blk(v), blk(log_g)
    b = jnp.cumsum(log_g, axis=2)
    b_last = b[:, :, -1]
    q_dec = q * jnp.exp(b)
    att = jnp.einsum('bnihd,bnjhd->bnhij', q_dec, k * jnp.exp(-b))
    att = jnp.where(jnp.tril(jnp.ones((CHUNK, CHUNK), dtype=bool)), att, 0.0)
    o_intra = jnp.einsum('bnhij,bnjhe->bnihe', att, v)
    k_tail = k * jnp.exp(b_last[:, :, None] - b)

    def step(S, xs):
        qd, kt, vc, bl = xs
        o = jnp.einsum('bihd,bhde->bihe', qd, S)
        S = S * jnp.exp(bl)[..., None] + jnp.einsum('bjhd,bjhe->bhde', kt, vc)
        return S, o

    S0 = jnp.zeros((B, H, dk, v.shape[-1]), jnp.float32)
    xs = tuple(jnp.moveaxis(t, 1, 0) for t in (q_dec, k_tail, v, b_last))
    _, o_inter = lax.scan(step, S0, xs)
    return (o_intra + jnp.moveaxis(o_inter, 0, 1)).reshape(B, T, H, -1)


def bidir_gla(q, k_f, k_b, v, lg_f, lg_b):
    flip = lambda t: jnp.flip(t, axis=1)
    return gla_chunk(q, k_f, v, lg_f) + flip(gla_chunk(flip(q), flip(k_b), flip(v), flip(lg_b)))


def _lin_combine(left, right):
    a1, b1 = left
    a2, b2 = right
    return a1 * a2, a2 * b1 + b2


def rglru(x, wa, ba, wx, bx, lam, reverse):
    B, T, C = x.shape
    xb = x.reshape(B, T, C_BLOCKS, C_BLOCK)
    r = jax.nn.sigmoid(jnp.einsum('btnk,nkj->btnj', xb, wa).reshape(B, T, C) + ba)
    i = jax.nn.sigmoid(jnp.einsum('btnk,nkj->btnj', xb, wx).reshape(B, T, C) + bx)
    log_a = -RG_C * r * jax.nn.softplus(-lam)
    a = jnp.exp(log_a)
    u = jnp.sqrt(-jnp.expm1(2.0 * log_a)) * (i * x)
    _, h = lax.associative_scan(_lin_combine, (a, u), axis=1, reverse=reverse)
    return h


def token_mixers(h, w_in, lb, hgrn_norm_w, gla_up_w, gla_up_b, gla_norm_w,
                 c_conv_w, c_conv_b, rglru_wa, rglru_ba, rglru_wx, rglru_bx, rglru_lam,
                 w_branch, w_out):
    B, T, _ = h.shape
    f32 = lambda t: t.astype(jnp.float32)
    heads = lambda t, n: t.reshape(B, T, n, -1)
    parts = jnp.split(h @ w_in, np.cumsum(IN_SPLITS)[:-1].tolist(), axis=-1)
    (q_a, zf_a, zb_a, i_a, og_a, q_b, k_b, v_b, og_b, lrf_b, lrb_b,
     x_c, y_c, g_a, g_b, g_c) = parts

    lbf = f32(lb)
    lg_af = jnp.log(lbf[0] + (1.0 - lbf[0]) * jax.nn.sigmoid(f32(zf_a)))
    lg_ab = jnp.log(lbf[1] + (1.0 - lbf[1]) * jax.nn.sigmoid(f32(zb_a)))
    o_a = bidir_gla(heads(jax.nn.silu(f32(q_a)), A_HEADS),
                    heads(-jnp.expm1(lg_af), A_HEADS), heads(-jnp.expm1(lg_ab), A_HEADS),
                    heads(f32(i_a), A_HEADS),
                    heads(lg_af, A_HEADS), heads(lg_ab, A_HEADS))
    o_a = (rms_norm(o_a, hgrn_norm_w).reshape(B, T, A_VAL) * jax.nn.silu(f32(og_a))).astype(h.dtype)

    up_w, up_b = f32(gla_up_w), f32(gla_up_b)
    lg_bf = jax.nn.log_sigmoid(f32(lrf_b) @ up_w[0] + up_b[0]) / GLA_NORMALIZER
    lg_bb = jax.nn.log_sigmoid(f32(lrb_b) @ up_w[1] + up_b[1]) / GLA_NORMALIZER
    kb = heads(f32(k_b), B_HEADS)
    o_b = bidir_gla(heads(f32(q_b), B_HEADS), kb, kb, heads(f32(v_b), B_HEADS),
                    heads(lg_bf, B_HEADS), heads(lg_bb, B_HEADS))
    o_b = (rms_norm(o_b, gla_norm_w).reshape(B, T, B_VAL) * jax.nn.silu(f32(og_b))).astype(h.dtype)

    xc = f32(dw_conv(x_c, c_conv_w, c_conv_b, C_CONV // 2))
    hc = (rglru(xc, rglru_wa[0], rglru_ba[0], rglru_wx[0], rglru_bx[0], rglru_lam[0], False)
          + rglru(xc, rglru_wa[1], rglru_ba[1], rglru_wx[1], rglru_bx[1], rglru_lam[1], True))
    o_c = (hc * jax.nn.gelu(f32(y_c))).astype(h.dtype)

    m = (jax.nn.sigmoid(g_a) * (o_a @ w_branch[0])
         + jax.nn.sigmoid(g_b) * (o_b @ w_branch[1])
         + jax.nn.sigmoid(g_c) * (o_c @ w_branch[2]))
    return m @ w_out


def conv_ffn(h, ffn_up, ffn_conv_w, ffn_conv_b, ffn_down):
    u = dw_conv(h @ ffn_up, ffn_conv_w, ffn_conv_b, FFN_CONV // 2)
    gate, val = jnp.split(u, 2, axis=-1)
    return (jax.nn.gelu(gate) * val) @ ffn_down


def trunk(x, norm_mix_w, w_in, hgrn_lb_logits, hgrn_norm_w, gla_up_w, gla_up_b, gla_norm_w,
          c_conv_w, c_conv_b, rglru_wa, rglru_ba, rglru_wx, rglru_bx, rglru_lam,
          w_branch, w_out, norm_ffn_w, ffn_up, ffn_conv_w, ffn_conv_b, ffn_down, final_norm_w):
    lb_all = jnp.cumsum(jax.nn.softmax(hgrn_lb_logits.astype(jnp.float32), axis=0), axis=0)
    lb_all = lb_all - lb_all[0]
    for l in range(DEPTH):
        h = rms_norm(x, norm_mix_w[l])
        x = x + token_mixers(h, w_in[l], lb_all[l], hgrn_norm_w[l], gla_up_w[l], gla_up_b[l],
                             gla_norm_w[l], c_conv_w[l], c_conv_b[l], rglru_wa[l], rglru_ba[l],
                             rglru_wx[l], rglru_bx[l], rglru_lam[l], w_branch[l], w_out[l]).astype(x.dtype)
        h = rms_norm(x, norm_ffn_w[l])
        x = x + conv_ffn(h, ffn_up[l], ffn_conv_w[l], ffn_conv_b[l], ffn_down[l]).astype(x.dtype)
    return rms_norm(x, final_norm_w)


def setup_inputs(seed: int = 0) -> dict:
    key = jax.random.key(seed)
    ks = jax.random.split(key, 26)
    nrm = lambda k, shape, scale: jax.random.normal(k, shape, jnp.float32) * scale
    gain = lambda k, shape: 1.0 + 0.05 * jax.random.normal(k, shape, jnp.float32)
    u = jax.random.uniform(ks[15], (DEPTH, 2, C_WIDTH), jnp.float32, minval=0.9, maxval=0.999)
    p = u ** (1.0 / RG_C)
    lam = jnp.log(p) - jnp.log1p(-p)
    return {
        'x_prompt': nrm(ks[0], (BATCH, SEQ, D_MODEL), 1.0),
        'x_sample': nrm(ks[1], (DEC_BATCH, DEC_SEQ, D_MODEL), 1.0),
        'norm_mix_w': gain(ks[2], (DEPTH, D_MODEL)),
        'w_in': nrm(ks[3], (DEPTH, D_MODEL, N_IN), D_MODEL ** -0.5),
        'hgrn_lb_logits': nrm(ks[4], (DEPTH, 2, A_KEY), 0.5),
        'hgrn_norm_w': gain(ks[5], (DEPTH, A_HEAD_V)),
        'gla_up_w': nrm(ks[6], (DEPTH, 2, GLA_RANK, B_KEY), GLA_RANK ** -0.5),
        'gla_up_b': nrm(ks[7], (DEPTH, 2, B_KEY), 0.1),
        'gla_norm_w': gain(ks[8], (DEPTH, B_HEAD_V)),
        'c_conv_w': nrm(ks[9], (DEPTH, C_CONV, C_WIDTH), C_CONV ** -0.5),
        'c_conv_b': nrm(ks[10], (DEPTH, C_WIDTH), 0.02),
        'rglru_wa': nrm(ks[11], (DEPTH, 2, C_BLOCKS, C_BLOCK, C_BLOCK), C_BLOCK ** -0.5),
        'rglru_ba': nrm(ks[12], (DEPTH, 2, C_WIDTH), 0.1),
        'rglru_wx': nrm(ks[13], (DEPTH, 2, C_BLOCKS, C_BLOCK, C_BLOCK), C_BLOCK ** -0.5),
        'rglru_bx': nrm(ks[14], (DEPTH, 2, C_WIDTH), 0.1),
        'rglru_lam': lam,
        'w_branch': nrm(ks[16], (DEPTH, N_BRANCH, BRANCH_WIDTH, D_MODEL), BRANCH_WIDTH ** -0.5),
        'w_out': nrm(ks[17], (DEPTH, D_MODEL, D_MODEL), D_MODEL ** -0.5),
        'norm_ffn_w': gain(ks[18], (DEPTH, D_MODEL)),
        'ffn_up': nrm(ks[19], (DEPTH, D_MODEL, 2 * D_FF), D_MODEL ** -0.5),
        'ffn_conv_w': nrm(ks[20], (DEPTH, FFN_CONV, 2 * D_FF), FFN_CONV ** -0.5),
        'ffn_conv_b': nrm(ks[21], (DEPTH, 2 * D_FF), 0.02),
        'ffn_down': nrm(ks[22], (DEPTH, D_FF, D_MODEL), D_FF ** -0.5),
        'final_norm_w': gain(ks[23], (D_MODEL,)),
    }


def reference(x_prompt, x_sample, norm_mix_w, w_in, hgrn_lb_logits, hgrn_norm_w, gla_up_w, gla_up_b,
              gla_norm_w, c_conv_w, c_conv_b, rglru_wa, rglru_ba, rglru_wx, rglru_bx, rglru_lam,
              w_branch, w_out, norm_ffn_w, ffn_up, ffn_conv_w, ffn_conv_b, ffn_down, final_norm_w):
    run = functools.partial(
        trunk, norm_mix_w=norm_mix_w, w_in=w_in, hgrn_lb_logits=hgrn_lb_logits, hgrn_norm_w=hgrn_norm_w,
        gla_up_w=gla_up_w, gla_up_b=gla_up_b, gla_norm_w=gla_norm_w, c_conv_w=c_conv_w, c_conv_b=c_conv_b,
        rglru_wa=rglru_wa, rglru_ba=rglru_ba, rglru_wx=rglru_wx, rglru_bx=rglru_bx, rglru_lam=rglru_lam,
        w_branch=w_branch, w_out=w_out, norm_ffn_w=norm_ffn_w, ffn_up=ffn_up, ffn_conv_w=ffn_conv_w,
        ffn_conv_b=ffn_conv_b, ffn_down=ffn_down, final_norm_w=final_norm_w)
    y_prompt = run(x_prompt)
    y_sample = run(x_sample)
    return (y_prompt, y_sample)
```

```cpp
#include <hip/hip_runtime.h>
#include <hip/hip_cooperative_groups.h>
#include <cstdio>
namespace cg = cooperative_groups;

#define LAS __attribute__((address_space(3)))
typedef unsigned short bf16_t;
typedef short bf16x8 __attribute__((ext_vector_type(8)));
typedef float f32x4 __attribute__((ext_vector_type(4)));
typedef float f32x2 __attribute__((ext_vector_type(2)));
typedef unsigned u32x4 __attribute__((ext_vector_type(4)));
typedef unsigned u32x2 __attribute__((ext_vector_type(2)));

constexpr int DM = 1024, SEQ = 8192, NSEQ = 6, DEPTH = 4;
constexpr int GS = 2;
constexpr int MG = GS * SEQ;
constexpr int NGRP = NSEQ / GS;
constexpr int NIN = 8224, NINP = 8448;
constexpr int DFF = 2816;
constexpr int LSC = 256, NSC = SEQ / LSC;
constexpr int LCC = 64, NCC = SEQ / LCC;
constexpr int NTHR = 512;
constexpr int LDS_BYTES = 131072 + 256;
constexpr float EPS = 1e-6f;

constexpr size_t WS_WIN  = 0;
constexpr size_t WS_WB   = WS_WIN  + (size_t)NINP * DM * 2;
constexpr size_t WS_WOUT = WS_WB   + (size_t)3 * DM * 512 * 2;
constexpr size_t WS_WUP  = WS_WOUT + (size_t)DM * DM * 2;
constexpr size_t WS_WDN  = WS_WUP  + (size_t)2 * DFF * DM * 2;
constexpr size_t WS_H    = WS_WDN  + (size_t)DM * DFF * 2;
constexpr size_t WS_PROJ = WS_H    + (size_t)MG * DM * 2;
constexpr size_t PTILE   = (size_t)MG * 256;
constexpr size_t WS_O    = WS_PROJ + 33 * PTILE * 2;
constexpr size_t WS_SA   = WS_O    + (size_t)3 * MG * 512 * 2;
constexpr size_t WS_SB   = WS_SA   + (size_t)GS * 4 * 2 * NSC * 128 * 128 * 4;
constexpr size_t WS_DA   = WS_SB   + (size_t)GS * 4 * 2 * NSC * 128 * 64 * 4;
constexpr size_t WS_DB   = WS_DA   + (size_t)GS * 4 * 2 * NSC * 128 * 4;
constexpr size_t WS_CH   = WS_DB   + (size_t)GS * 4 * 2 * NSC * 64 * 4;
constexpr size_t WS_CP   = WS_CH   + (size_t)GS * NCC * 2 * 512 * 4;
constexpr size_t WS_BAR  = WS_CP   + (size_t)GS * NCC * 2 * 512 * 4;
constexpr size_t WS_END  = WS_BAR  + 16384;
static_assert((size_t)MG * 2 * DFF * 2 <= 33 * PTILE * 2, "u buffer fits the projection region");
static_assert((size_t)MG * DFF * 2 <= WS_DA - WS_O, "g buffer fits o + state region");

struct Params { const float* in[24]; float* out; unsigned char* ws; };

__device__ __forceinline__ float bf2f(unsigned b) { return __uint_as_float(b << 16); }
__device__ __forceinline__ unsigned f2bf(float f) { unsigned u = __float_as_uint(f); return (u + 0x7fffu + ((u >> 16) & 1u)) >> 16; }
__device__ __forceinline__ unsigned pk2(float lo, float hi) { return f2bf(lo) | (f2bf(hi) << 16); }
__device__ __forceinline__ float sigmoidf_(float x) { return 1.0f / (1.0f + __expf(-x)); }
__device__ __forceinline__ float gelu_tanh(float x) { const float t = 1.5957691216057308f * (x + 0.044715f * x * x * x); return x / (1.0f + __expf(-t)); }
__device__ __forceinline__ float wave_sum(float v) {
#pragma unroll
    for (int o = 32; o >= 1; o >>= 1) v += __shfl_xor(v, o);
    return v;
}

namespace pg8 {
#define PG8_LAS __attribute__((address_space(3)))
typedef unsigned short bf16_t;
typedef short bf16x8 __attribute__((ext_vector_type(8)));
typedef float f32x4 __attribute__((ext_vector_type(4)));
typedef unsigned u32x4 __attribute__((ext_vector_type(4)));
constexpr int BM = 256, BK = 64, HALF = 128, HTB = HALF * BK * 2  , STAGE_BYTES = 8 * HTB, NXCD = 8, WGM = 8;

__host__ __device__ __forceinline__ int lds_byte(int r, int c) { const int st = (r >> 4) * 2 + (c >> 5), rr = r & 15, cc = c & 31, ob = rr * 64 + cc * 2; return st * 1024 + (ob ^ (((ob >> 9) & 1) << 5)); }
__host__ __device__ __forceinline__ void stage_rc(int b, int& R, int& C) { const int st = b / 1024, sb = b % 1024, swz = sb ^ (((sb >> 9) & 1) << 5); R = (st >> 1) * 16 + swz / 64; C = (st & 1) * 32 + (swz % 64) / 2; }
__host__ __device__ __forceinline__ int perm32(int rho) { const int n = rho >> 4, i = rho & 15; return 8 * (i >> 2) + 4 * n + (i & 3); }

struct Unit { int pm, pn; };
struct Gemm { const bf16_t* A; const bf16_t* Bt; int M, N, K; };

struct StaticOrder {
    int nM, nN, nwg, G, c;
    __host__ __device__ void init(int M, int N, int G_, int c_) { nM = M / BM; nN = N / BM; nwg = nM * nN; G = G_; c = c_; }
    __host__ __device__ bool next(int i, Unit& u) const {
        const long L = (long)i * G + c; if (L >= nwg) return false;
        int wgid = (int)L; { const int q = nwg / NXCD, r = nwg % NXCD, xcd = wgid % NXCD, off = wgid / NXCD; wgid = (xcd < r ? xcd * (q + 1) : r * (q + 1) + (xcd - r) * q) + off; }
        const int nig = WGM * nN, gid = wgid / nig, fm = gid * WGM, gsz = (nM - fm) < WGM ? (nM - fm) : WGM;
        u.pm = fm + ((wgid % nig) % gsz); u.pn = (wgid % nig) / gsz; return true;
    }
    __device__ __forceinline__ void a_ready(const Unit&) const {}
    __device__ __forceinline__ void done(const Unit&) const {}
};
__device__ __forceinline__ unsigned cvt_pk_bf16(float lo, float hi) { unsigned r; asm volatile("v_cvt_pk_bf16_f32 %0, %1, %2" : "=v"(r) : "v"(lo), "v"(hi)); return r; }
typedef float f32x2 __attribute__((ext_vector_type(2)));
template <class Epi, class Sched>
__device__ __forceinline__ void gemm_phase(PG8_LAS unsigned char* lds, const Gemm g, const Sched& S, const Epi& E) {
    int tid_ = threadIdx.x; asm volatile("" : "+v"(tid_));
    const int tid = tid_, wid = __builtin_amdgcn_readfirstlane(tid >> 6), lane = tid & 63, wr = wid >> 2, wc = wid & 3, fr = lane & 15, fq = lane >> 4;
    int K_ = g.K; asm volatile("" : "+s"(K_));
    const int K = K_, nt = K / BK;
    unsigned voffA[2], voffB[2];
#pragma unroll
    for (int i = 0; i < 2; ++i) { int R, C; stage_rc(tid * 16 + i * 8192, R, C); const int Rb = Epi::PERM ? ((R & ~31) + perm32(R & 31)) : R;
        voffA[i] = (unsigned)(R * K + C) * 2u; voffB[i] = (unsigned)(Rb * K + C) * 2u; }
    const size_t kstep = (size_t)(BK * 2);
    const size_t hstep = (size_t)HALF * K * 2;
    const size_t tstep = 2 * hstep;
    const unsigned ldsw = (unsigned)wid * 1024u;
    const int aoff = lds_byte(wr * 64 + fr, fq * 8), boff = lds_byte(wc * 32 + fr, fq * 8);
#define PG8_SA(b, h) (((b) * 2 + (h)) * HTB)
#define PG8_SB(b, h) ((4 + (b) * 2 + (h)) * HTB)
#define PG8_STAGE(bufoff, gbase, voff) do { _Pragma("unroll") for (int _i = 0; _i < 2; ++_i) \
        __builtin_amdgcn_global_load_lds((const unsigned*)((const char*)(gbase) + (voff)[_i]), (PG8_LAS unsigned*)(lds + (bufoff) + ldsw + _i * 8192), 16, 0, 0); } while (0)
#define PG8_LDA(dst, b, h) do { _Pragma("unroll") for (int m = 0; m < 4; ++m) _Pragma("unroll") for (int k = 0; k < 2; ++k) dst[m][k] = *(const PG8_LAS bf16x8*)(lds + PG8_SA(b, h) + aoff + m * 2048 + k * 1024); } while (0)
#define PG8_LDB(dst, b, h) do { _Pragma("unroll") for (int n = 0; n < 2; ++n) _Pragma("unroll") for (int k = 0; k < 2; ++k) dst[n][k] = *(const PG8_LAS bf16x8*)(lds + PG8_SB(b, h) + boff + n * 2048 + k * 1024); } while (0)
#define PG8_MMA(ai, bj, At, Bt) do { __builtin_amdgcn_s_setprio(1); _Pragma("unroll") for (int m = 0; m < 4; ++m) _Pragma("unroll") for (int n = 0; n < 2; ++n) _Pragma("unroll") for (int k = 0; k < 2; ++k) \
        acc[ai][bj][m][n] = __builtin_amdgcn_mfma_f32_16x16x32_bf16(Bt[n][k], At[m][k], acc[ai][bj][m][n], 0, 0, 0); __builtin_amdgcn_s_setprio(0); } while (0)
#define PG8_WAIT_V(n) asm volatile("s_waitcnt vmcnt(" #n ")" ::: "memory")
#define PG8_WAIT_L(n) asm volatile("s_waitcnt lgkmcnt(" #n ")" ::: "memory")
#define PG8_BAR __builtin_amdgcn_s_barrier()
#define PG8_SCHED __builtin_amdgcn_sched_barrier(0)
    Unit cur, nxt; int ui = 0;
    if (!S.next(0, cur)) return;
    f32x4 acc[2][2][4][2];
#pragma unroll
    for (int a = 0; a < 2; ++a)
#pragma unroll
        for (int b = 0; b < 2; ++b)
#pragma unroll
            for (int m = 0; m < 4; ++m)
#pragma unroll
                for (int n = 0; n < 2; ++n) acc[a][b][m][n] = (f32x4){0.f, 0.f, 0.f, 0.f};
    bf16x8 At[4][2], B0[2][2], B1[2][2];
    const char* cA = (const char*)g.A + (size_t)cur.pm * tstep; const char* cB = (const char*)g.Bt + (size_t)cur.pn * tstep;
    S.a_ready(cur);
    PG8_STAGE(PG8_SB(0, 0), cB, voffB); PG8_STAGE(PG8_SA(0, 0), cA, voffA); PG8_STAGE(PG8_SB(0, 1), cB + hstep, voffB); PG8_STAGE(PG8_SA(0, 1), cA + hstep, voffA);
    if (wr == 1) PG8_BAR;
    PG8_WAIT_V(4); PG8_BAR;
    PG8_STAGE(PG8_SB(1, 0), cB + kstep, voffB); PG8_STAGE(PG8_SA(1, 0), cA + kstep, voffA); PG8_STAGE(PG8_SB(1, 1), cB + hstep + kstep, voffB);
    PG8_WAIT_V(6); PG8_BAR;
    for (;;) {
        const bool has_next = S.next(ui + 1, nxt);
        const char* nA = has_next ? (const char*)g.A + (size_t)nxt.pm * tstep : cA; const char* nB = has_next ? (const char*)g.Bt + (size_t)nxt.pn * tstep : cB;
#pragma unroll 1
        for (int t = 0; t < nt; t += 2) {
            const bool last = (t == nt - 2);
            const char* a1 = cA + (size_t)(t + 1) * kstep;
            const char* a2 = last ? nA : cA + (size_t)(t + 2) * kstep; const char* b2 = last ? nB : cB + (size_t)(t + 2) * kstep;
            const char* a3 = a2 + kstep; const char* b3 = b2 + kstep;
            if (last && has_next) S.a_ready(nxt);
            PG8_LDB(B0, 0, 0); PG8_SCHED; PG8_LDA(At, 0, 0); PG8_STAGE(PG8_SA(1, 1), a1 + hstep, voffA);
            PG8_WAIT_L(8); PG8_BAR; PG8_WAIT_L(0); PG8_MMA(0, 0, At, B0); PG8_BAR; PG8_SCHED;
            PG8_LDB(B1, 0, 1); PG8_STAGE(PG8_SB(0, 0), b2, voffB);
            PG8_BAR; PG8_WAIT_L(0); PG8_MMA(0, 1, At, B1); PG8_BAR;
            PG8_LDA(At, 0, 1); PG8_STAGE(PG8_SA(0, 0), a2, voffA);
            PG8_BAR; PG8_WAIT_L(0); PG8_MMA(1, 0, At, B0); PG8_BAR; PG8_SCHED;
            PG8_STAGE(PG8_SB(0, 1), b2 + hstep, voffB);
            PG8_WAIT_V(6); PG8_BAR; PG8_MMA(1, 1, At, B1); PG8_BAR;
            PG8_LDB(B0, 1, 0); PG8_SCHED; PG8_LDA(At, 1, 0); PG8_STAGE(PG8_SA(0, 1), a2 + hstep, voffA);
            PG8_WAIT_L(8); PG8_BAR; PG8_WAIT_L(0); PG8_MMA(0, 0, At, B0); PG8_BAR; PG8_SCHED;
            PG8_LDB(B1, 1, 1); PG8_STAGE(PG8_SB(1, 0), b3, voffB);
            PG8_BAR; PG8_WAIT_L(0); PG8_MMA(0, 1, At, B1); PG8_BAR;
            PG8_LDA(At, 1, 1); PG8_STAGE(PG8_SA(1, 0), a3, voffA);
            PG8_BAR; PG8_WAIT_L(0); PG8_MMA(1, 0, At, B0); PG8_BAR; PG8_SCHED;
            PG8_STAGE(PG8_SB(1, 1), b3 + hstep, voffB);
            PG8_WAIT_V(6); PG8_BAR; PG8_MMA(1, 1, At, B1); PG8_BAR;
        }
        if constexpr (!Epi::AFTER_DRAIN) { E(acc, cur, wr, wc, fr, fq); S.done(cur); }
        if (!has_next) break;
#pragma unroll
        for (int a = 0; a < 2; ++a)
#pragma unroll
            for (int b = 0; b < 2; ++b)
#pragma unroll
                for (int m = 0; m < 4; ++m)
#pragma unroll
                    for (int n = 0; n < 2; ++n) acc[a][b][m][n] = (f32x4){0.f, 0.f, 0.f, 0.f};
        cur = nxt; cA = nA; cB = nB; ++ui;
    }
    PG8_WAIT_V(0);
    if (wr == 0) PG8_BAR;
    PG8_BAR;
    if constexpr (Epi::AFTER_DRAIN) { E.fused(acc, cur, wr, wc, fr, fq, lds, wid, lane); S.done(cur); }
#undef PG8_SA
#undef PG8_SB
#undef PG8_STAGE
#undef PG8_LDA
#undef PG8_LDB
#undef PG8_MMA
#undef PG8_WAIT_V
#undef PG8_WAIT_L
#undef PG8_BAR
#undef PG8_SCHED
}
}
#define XB_TMO      128
#define XB_XCNT(j)  (256  + 64 * (j))
#define XB_XSUB(j)  (1280 + 64 * (j))
#define XB_XGEN(j)  (2304 + 64 * (j))
#define XB_TOP      3328
#define XB_TOPGEN   3392
#define XCD_BAR_WORDS 3456
#define XB_SPIN_CAP (1u << 18)

__device__ __forceinline__ unsigned xb_ld(unsigned* p)              { return __hip_atomic_load(p, __ATOMIC_RELAXED, __HIP_MEMORY_SCOPE_AGENT); }
__device__ __forceinline__ unsigned xb_add(unsigned* p, unsigned v) { return __hip_atomic_fetch_add(p, v, __ATOMIC_RELAXED, __HIP_MEMORY_SCOPE_AGENT); }
__device__ __forceinline__ unsigned xb_xcc_id() { return (unsigned)__builtin_amdgcn_s_getreg((3 << 11) | 20) & 0xFu; }
#define XB_SPIN(cond, bar) do { unsigned _sp = 0; while (cond) { __builtin_amdgcn_s_sleep(1); \
    if ((++_sp & 255u) == 0u) { if (xb_ld(&(bar)[XB_TMO])) break; if (_sp > XB_SPIN_CAP) { atomicAdd(&(bar)[XB_TMO], 1u); break; } } } } while (0)

struct XcdBarrier {
    unsigned* bar; unsigned x;
    volatile LAS unsigned* st;
};

__device__ __forceinline__ XcdBarrier xcd_barrier_post(unsigned* bar, volatile LAS unsigned* st) {
    XcdBarrier b; b.bar = bar; b.x = xb_xcc_id(); b.st = st;
    if (threadIdx.x == 0) (void)xb_add(&bar[XB_XCNT(b.x)], 1u);
    return b;
}
__device__ __forceinline__ void xcd_barrier_complete(unsigned* bar, unsigned x, unsigned& nloc, unsigned& nx) {
    const unsigned G = gridDim.x * gridDim.y * gridDim.z;
    unsigned sum, cnt, mine, sp = 0u;
    for (;;) {
        sum = 0u; cnt = 0u; mine = 0u;
#pragma unroll
        for (unsigned j = 0; j < 16; ++j) { const unsigned c = xb_ld(&bar[XB_XCNT(j)]); sum += c; cnt += (c > 0u) ? 1u : 0u; mine = (j == x) ? c : mine; }
        if (sum == G) break;
        __builtin_amdgcn_s_sleep(1);
        if ((++sp & 255u) == 0u) { if (xb_ld(&bar[XB_TMO])) break; if (sp > XB_SPIN_CAP) { atomicAdd(&bar[XB_TMO], 1u); break; } }
    }
    nloc = mine > 0u ? mine : 1u; nx = cnt > 0u ? cnt : 1u;
}

__device__ __forceinline__ void xcd_barrier(const XcdBarrier& b) {
    asm volatile("s_waitcnt vmcnt(0)" ::: "memory");
    __syncthreads();
    if (threadIdx.x == 0) {
        unsigned* bar = b.bar;
        __builtin_amdgcn_s_waitcnt(0);
        unsigned nloc = b.st[0], nx = b.st[1];
        if (nloc == 0u) { xcd_barrier_complete(bar, b.x, nloc, nx); b.st[0] = nloc; b.st[1] = nx; }
        const unsigned old = xb_add(&bar[XB_XSUB(b.x)], 1u);
        const unsigned gen = old / nloc;
        if (old + 1u == (gen + 1u) * nloc) {
            __builtin_amdgcn_fence(__ATOMIC_RELEASE, "agent");
            asm volatile("s_waitcnt vmcnt(0)" ::: "memory");
            const unsigned og = xb_add(&bar[XB_TOP], 1u);
            const unsigned tg = og / nx;
            if (og + 1u == (tg + 1u) * nx) xb_add(&bar[XB_TOPGEN], 1u);
            else XB_SPIN(xb_ld(&bar[XB_TOPGEN]) == tg, bar);
            __builtin_amdgcn_fence(__ATOMIC_ACQUIRE, "agent");
            xb_add(&bar[XB_XGEN(b.x)], 1u);
            asm volatile("s_waitcnt vmcnt(0)" ::: "memory");
        } else {
            XB_SPIN(xb_ld(&bar[XB_XGEN(b.x)]) == gen, bar);
            __builtin_amdgcn_fence(__ATOMIC_ACQUIRE, "agent");
            asm volatile("s_waitcnt vmcnt(0)" ::: "memory");
        }
    }
    __syncthreads();
}

using pg8::Unit; using pg8::Gemm;

struct EpiStoreBf16 {
    static constexpr bool PERM = true, AFTER_DRAIN = false;
    bf16_t* O; int ldc; int tile_major;
    __device__ __forceinline__ void operator()(const f32x4 (&acc)[2][2][4][2], const Unit& u, int wr, int wc, int fr, int fq) const {
        const int row0 = u.pm * 256 + wr * 64 + fr; bf16_t* base = O; int colt = u.pn * 256;
        if (tile_major) { base += (size_t)u.pn * PTILE; colt = 0; }
        const int col0 = colt + wc * 32 + 8 * fq;
#pragma unroll
        for (int ai = 0; ai < 2; ++ai)
#pragma unroll
            for (int m = 0; m < 4; ++m) { bf16_t* rowp = base + (size_t)(row0 + ai * 128 + m * 16) * ldc + col0;
#pragma unroll
                for (int bj = 0; bj < 2; ++bj) { const f32x4 v0 = acc[ai][bj][m][0], v1 = acc[ai][bj][m][1];
                    u32x4 w; w.x = pg8::cvt_pk_bf16(v0[0], v0[1]); w.y = pg8::cvt_pk_bf16(v0[2], v0[3]); w.z = pg8::cvt_pk_bf16(v1[0], v1[1]); w.w = pg8::cvt_pk_bf16(v1[2], v1[3]);
                    *(u32x4*)(rowp + bj * 128) = w; } }
    }
};
struct EpiGate {
    static constexpr bool PERM = false, AFTER_DRAIN = false;
    const bf16_t* proj; float* mtmp; bf16_t* mb; int nM;
    __device__ __forceinline__ void operator()(const f32x4 (&acc)[2][2][4][2], const Unit& u, int wr, int wc, int fr, int fq) const {
        const int b = u.pm / nM, pm = u.pm - b * nM, pn = u.pn & 3;
        const bf16_t* gt = proj + (size_t)(20 + 4 * b + pn) * PTILE;
        const int row0 = pm * 256 + wr * 64 + fr, colin = wc * 32 + 4 * fq;
#pragma unroll
        for (int ai = 0; ai < 2; ++ai)
#pragma unroll
            for (int m = 0; m < 4; ++m) { const int r = row0 + ai * 128 + m * 16;
#pragma unroll
                for (int bj = 0; bj < 2; ++bj)
#pragma unroll
                    for (int n = 0; n < 2; ++n) { const int cin = colin + bj * 128 + n * 16;
                        const u32x2 gw = *(const u32x2*)(gt + (size_t)r * 256 + cin);
                        f32x4 g; g[0] = sigmoidf_(bf2f(gw.x & 0xffffu)); g[1] = sigmoidf_(bf2f(gw.x >> 16)); g[2] = sigmoidf_(bf2f(gw.y & 0xffffu)); g[3] = sigmoidf_(bf2f(gw.y >> 16));
                        f32x4 v = acc[ai][bj][m][n] * g;
                        float* mp = mtmp + (size_t)r * 1024 + pn * 256 + cin;
                        if (b > 0) v += *(const f32x4*)mp;
                        if (b < 2) *(f32x4*)mp = v;
                        else { u32x2 w; w.x = pg8::cvt_pk_bf16(v[0], v[1]); w.y = pg8::cvt_pk_bf16(v[2], v[3]); *(u32x2*)(mb + (size_t)r * 1024 + pn * 256 + cin) = w; } } }
    }
};
struct EpiResid {
    static constexpr bool PERM = false, AFTER_DRAIN = false;
    float* x;
    __device__ __forceinline__ void operator()(const f32x4 (&acc)[2][2][4][2], const Unit& u, int wr, int wc, int fr, int fq) const {
        const int row0 = u.pm * 256 + wr * 64 + fr, col0 = u.pn * 256 + wc * 32 + 4 * fq;
#pragma unroll
        for (int ai = 0; ai < 2; ++ai)
#pragma unroll
            for (int m = 0; m < 4; ++m) { float* rowp = x + (size_t)(row0 + ai * 128 + m * 16) * 1024 + col0;
#pragma unroll
                for (int bj = 0; bj < 2; ++bj)
#pragma unroll
                    for (int n = 0; n < 2; ++n) { float* q = rowp + bj * 128 + n * 16; *(f32x4*)q = *(const f32x4*)q + acc[ai][bj][m][n]; } }
    }
};
struct BranchOrder {
    int nM, G, c;
    __device__ __forceinline__ bool next(int i, Unit& u) const {
        const int tile = c + (i / 3) * G, b = i % 3; if (tile >= nM * 4) return false;
        u.pm = b * nM + (tile >> 2); u.pn = b * 4 + (tile & 3); return true; }
    __device__ __forceinline__ void a_ready(const Unit&) const {}
    __device__ __forceinline__ void done(const Unit&) const {}
};

__device__ __forceinline__ void cvt_tile(const float* __restrict__ src, int ldsrc, int k0, int c0, int valid, bf16_t* __restrict__ dst, int lddst, int r0, LAS float* tile, int tid) {
    const int kk = tid >> 3, seg = (tid & 7) * 8;
    float4 a = make_float4(0.f, 0.f, 0.f, 0.f), b = a;
    if (seg + 8 <= valid) { const float4* p = (const float4*)(src + (size_t)(k0 + kk) * ldsrc + c0 + seg); a = p[0]; b = p[1]; }
    LAS float* t = tile + kk * 65 + seg;
    t[0] = a.x; t[1] = a.y; t[2] = a.z; t[3] = a.w; t[4] = b.x; t[5] = b.y; t[6] = b.z; t[7] = b.w;
    __syncthreads();
    const int n = tid >> 3, ks = (tid & 7) * 8;
    const LAS float* s = tile + ks * 65 + n;
    u32x4 w; w.x = pk2(s[0], s[65]); w.y = pk2(s[2 * 65], s[3 * 65]); w.z = pk2(s[4 * 65], s[5 * 65]); w.w = pk2(s[6 * 65], s[7 * 65]);
    *(u32x4*)(dst + (size_t)(r0 + n) * lddst + k0 + ks) = w;
    __syncthreads();
}
__device__ __forceinline__ void convert_phase(LAS unsigned char* lds, const Params& p, int l) {
    LAS float* tile = (LAS float*)lds; int tid_ = threadIdx.x; asm volatile("" : "+v"(tid_)); const int tid = tid_; unsigned char* ws = p.ws;
    for (int idx = blockIdx.x; idx < 4864; idx += gridDim.x) {
        int i = idx;
        if (i < 2112) { const int nb = i % 132, kb = i / 132, r0 = nb * 64; int c0, valid;
            if (r0 < 4096) { c0 = r0; valid = 64; } else if (r0 < 8192) { c0 = r0 + 32; valid = 64; } else if (r0 == 8192) { c0 = 4096; valid = 32; } else { c0 = 0; valid = 0; }
            cvt_tile(p.in[3] + (size_t)l * DM * NIN, NIN, kb * 64, c0, valid, (bf16_t*)(ws + WS_WIN), DM, r0, tile, tid); continue; }
        i -= 2112;
        if (i < 384) { const int b = i / 128, rem = i % 128, nb = rem % 16, kb = rem / 16;
            cvt_tile(p.in[16] + (size_t)(l * 3 + b) * 512 * DM, DM, kb * 64, nb * 64, 64, (bf16_t*)(ws + WS_WB) + (size_t)b * DM * 512, 512, nb * 64, tile, tid); continue; }
        i -= 384;
        if (i < 256) { const int nb = i % 16, kb = i / 16;
            cvt_tile(p.in[17] + (size_t)l * DM * DM, DM, kb * 64, nb * 64, 64, (bf16_t*)(ws + WS_WOUT), DM, nb * 64, tile, tid); continue; }
        i -= 256;
        if (i < 1408) { const int nb = i % 88, kb = i / 88;
            cvt_tile(p.in[19] + (size_t)l * DM * 2 * DFF, 2 * DFF, kb * 64, nb * 64, 64, (bf16_t*)(ws + WS_WUP), DM, nb * 64, tile, tid); continue; }
        i -= 1408;
        { const int nb = i % 16, kb = i / 16;
            cvt_tile(p.in[22] + (size_t)l * DFF * DM, DM, kb * 64, nb * 64, 64, (bf16_t*)(ws + WS_WDN), DFF, nb * 64, tile, tid); }
    }
}

__device__ __forceinline__ void norm_phase(const float* __restrict__ src, float* xcopy, const float* __restrict__ w, bf16_t* hb, int nrows) {
    int tid_ = threadIdx.x; asm volatile("" : "+v"(tid_));
    const int lane = tid_ & 63, wv = blockIdx.x * 8 + (tid_ >> 6), nwv = gridDim.x * 8;
    float4 wv4[4];
#pragma unroll
    for (int j = 0; j < 4; ++j) wv4[j] = ((const float4*)w)[lane + 64 * j];
    for (int row = wv; row < nrows; row += nwv) {
        const float4* pr = (const float4*)(src + (size_t)row * DM); float4 v[4]; float ss = 0.f;
#pragma unroll
        for (int j = 0; j < 4; ++j) { v[j] = pr[lane + 64 * j]; ss += v[j].x * v[j].x + v[j].y * v[j].y + v[j].z * v[j].z + v[j].w * v[j].w; }
        ss = wave_sum(ss); const float rs = rsqrtf(ss * (1.0f / DM) + EPS);
#pragma unroll
        for (int j = 0; j < 4; ++j) { u32x2 o; o.x = pk2(v[j].x * rs * wv4[j].x, v[j].y * rs * wv4[j].y); o.y = pk2(v[j].z * rs * wv4[j].z, v[j].w * rs * wv4[j].w);
            *(u32x2*)(hb + (size_t)row * DM + (lane + 64 * j) * 4) = o;
            if (xcopy) ((float4*)(xcopy + (size_t)row * DM))[lane + 64 * j] = v[j]; }
    }
}
__device__ __forceinline__ void final_norm_phase(float* x, const float* __restrict__ w, int nrows) {
    int tid_ = threadIdx.x; asm volatile("" : "+v"(tid_));
    const int lane = tid_ & 63, wv = blockIdx.x * 8 + (tid_ >> 6), nwv = gridDim.x * 8;
    float4 wv4[4];
#pragma unroll
    for (int j = 0; j < 4; ++j) wv4[j] = ((const float4*)w)[lane + 64 * j];
    for (int row = wv; row < nrows; row += nwv) {
        float4* pr = (float4*)(x + (size_t)row * DM); float4 v[4]; float ss = 0.f;
#pragma unroll
        for (int j = 0; j < 4; ++j) { v[j] = pr[lane + 64 * j]; ss += v[j].x * v[j].x + v[j].y * v[j].y + v[j].z * v[j].z + v[j].w * v[j].w; }
        ss = wave_sum(ss); const float rs = rsqrtf(ss * (1.0f / DM) + EPS);
#pragma unroll
        for (int j = 0; j < 4; ++j) pr[lane + 64 * j] = make_float4(v[j].x * rs * wv4[j].x, v[j].y * rs * wv4[j].y, v[j].z * rs * wv4[j].z, v[j].w * rs * wv4[j].w);
    }
}

#define WAVE_LDS_FENCE() asm volatile("s_waitcnt lgkmcnt(0)" ::: "memory")
#define MFMA16(a, b, c) __builtin_amdgcn_mfma_f32_16x16x32_bf16((a), (b), (c), 0, 0, 0)
constexpr int GC_STRIDE = 17408, GC_KD = 4352, GC_KTT = 8704, GC_VT = 12800, GC_DEC = 16896;
constexpr int GN_STB = 4 * GC_STRIDE, GN_ATT = GN_STB + 8 * 4352, GN_SSQ = GN_ATT + 8 * 512, GN_DSUM = GN_SSQ + 2048, GN_END = GN_DSUM + 2048;
static_assert(GN_END <= 131072, "GLA LDS map fits");

template <bool ISA, bool OUT, int DIR>
__device__ __forceinline__ void gla_dir(LAS unsigned char* lds, const Params& p, const int l, const int item) {
    constexpr int DK = ISA ? 128 : 64, DKP = 136, NKS = DK / 32, NNT = DK / 16;
    int tid_ = threadIdx.x; asm volatile("" : "+v"(tid_));
    const int tid = tid_, lane = tid & 63, wid = __builtin_amdgcn_readfirstlane(tid >> 6);
    const int s = item >> 7, h = (item >> 5) & 3, sc = item & 31;
    const int rowbase = s * SEQ + sc * LSC;
    const int l15 = lane & 15, lq = lane >> 4, e0 = wid * 16;
    const int ck = wid >> 1, hh = wid & 1;
    const bool prepqk = ISA || hh == 0;
    const int d = ISA ? hh * 64 + lane : lane, ev = hh * 64 + lane;
    unsigned char* ws = p.ws;
    const bf16_t* proj = (const bf16_t*)(ws + WS_PROJ);
    LAS bf16_t* STB = (LAS bf16_t*)(lds + GN_STB + wid * 4352); LAS bf16_t* ATT = (LAS bf16_t*)(lds + GN_ATT + wid * 512);
    LAS float* SSQ = (LAS float*)(lds + GN_SSQ); LAS float* DSUM = (LAS float*)(lds + GN_DSUM);
    const size_t hoff = (size_t)(h >> 1) * PTILE + (h & 1) * 128;
    const bf16_t* qT = ISA ? proj + hoff : proj + 10 * PTILE + h * 64;
    const bf16_t* vT = proj + (ISA ? 6 : 12) * PTILE + hoff;
    const bf16_t* ogT = proj + (ISA ? 8 : 14) * PTILE + hoff;
    const bf16_t* zT = ISA ? proj + (size_t)(2 + 2 * DIR) * PTILE + hoff : proj + 11 * PTILE + h * 64;
    const bf16_t* lrT = proj + 32 * PTILE + DIR * 16;
    const float qscale = ISA ? 0.08838834764831845f : 0.125f;
    float* ofw = (float*)(ws + WS_H);
    bf16_t* oout = (bf16_t*)(ws + WS_O) + (ISA ? (size_t)0 : (size_t)MG * 512);
    const float nw = (ISA ? p.in[5] : p.in[8])[l * 128 + e0 + l15];
    const bf16x8 zero8 = {0, 0, 0, 0, 0, 0, 0, 0};
    const int shd = (s * 4 + h) * 2 + DIR;
    float* Sg = (float*)(ws + (ISA ? WS_SA : WS_SB)) + ((size_t)shd * NSC + sc) * (size_t)(128 * DK);
    float* Dg = (float*)(ws + (ISA ? WS_DA : WS_DB)) + ((size_t)shd * NSC + sc) * DK;

    float lb = 0.f, upb = 0.f, upw[16];
    if (ISA) { const int c = h * 128 + d; float x[4], mx = -1e30f;
#pragma unroll
        for (int q = 0; q < 4; ++q) { x[q] = p.in[4][(q * 2 + DIR) * 512 + c]; mx = fmaxf(mx, x[q]); }
        float den = 0.f, num = 0.f;
#pragma unroll
        for (int q = 0; q < 4; ++q) { const float ex = __expf(x[q] - mx); den += ex; if (q >= 1 && q <= l) num += ex; }
        lb = num / den;
#pragma unroll
        for (int r = 0; r < 16; ++r) upw[r] = 0.f;
    } else {
#pragma unroll
        for (int r = 0; r < 16; ++r) upw[r] = p.in[6][(size_t)((l * 2 + DIR) * 16 + r) * 256 + h * 64 + d];
        upb = p.in[7][(l * 2 + DIR) * 256 + h * 64 + d];
    }
    f32x4 ST[NNT];
#pragma unroll
    for (int nt = 0; nt < NNT; ++nt)
#pragma unroll
        for (int r = 0; r < 4; ++r) ST[nt][r] = OUT ? Sg[(size_t)(e0 + lq * 4 + r) * DK + nt * 16 + l15] : 0.f;
    if (OUT) {
#pragma unroll
        for (int nt = 0; nt < NNT; ++nt)
#pragma unroll
            for (int r = 0; r < 4; ++r) STB[(lq * 4 + r) * DKP + nt * 16 + l15] = (bf16_t)f2bf(ST[nt][r]);
    }
    float dsum = 0.f;
    unsigned zq[16], vp[8];
#define GLA_LOADRAW(SS) do { const size_t rb_ = (size_t)(rowbase + (SS) * 64 + ck * 16) * 256; \
        _Pragma("unroll") for (int j = 0; j < 16; ++j) { const unsigned z_ = prepqk ? (unsigned)zT[rb_ + (size_t)j * 256 + d] : 0u; const unsigned q_ = (OUT && prepqk) ? (unsigned)qT[rb_ + (size_t)j * 256 + d] : 0u; zq[j] = z_ | (q_ << 16); } \
        _Pragma("unroll") for (int j = 0; j < 8; ++j) vp[j] = (unsigned)vT[rb_ + (size_t)(2 * j) * 256 + ev] | ((unsigned)vT[rb_ + (size_t)(2 * j + 1) * 256 + ev] << 16); } while (0)
    GLA_LOADRAW(DIR ? 3 : 0);
    __syncthreads();

#pragma unroll 1
    for (int ssi = 0; ssi < 4; ++ssi) {
        const int ss = DIR ? 3 - ssi : ssi;
        { LAS unsigned char* cb = lds + ck * GC_STRIDE;
          LAS bf16_t* QD = (LAS bf16_t*)cb; LAS bf16_t* KD = (LAS bf16_t*)(cb + GC_KD); LAS bf16_t* KTT = (LAS bf16_t*)(cb + GC_KTT); LAS bf16_t* VT = (LAS bf16_t*)(cb + GC_VT); LAS float* DEC = (LAS float*)(cb + GC_DEC);
          if (prepqk) {
            float lg[16], kk[16], qs[16], tot = 0.f;
            const size_t rb = (size_t)(rowbase + ss * 64 + ck * 16) * 256;
#pragma unroll
            for (int j = 0; j < 16; ++j) { const float a = bf2f(zq[j] & 0xffffu);
                if (ISA) { const float sg = sigmoidf_(a); lg[j] = __logf(lb + (1.f - lb) * sg); kk[j] = (1.f - lb) * (1.f - sg); const float q = bf2f(zq[j] >> 16); qs[j] = q * sigmoidf_(q) * qscale; }
                else { const u32x4 lo = *(const u32x4*)(lrT + rb + (size_t)j * 256), hi = *(const u32x4*)(lrT + rb + (size_t)j * 256 + 8);
                    const unsigned lw[8] = {lo.x, lo.y, lo.z, lo.w, hi.x, hi.y, hi.z, hi.w}; float y = upb;
#pragma unroll
                    for (int r = 0; r < 16; ++r) y += ((r & 1) ? bf2f(lw[r >> 1] >> 16) : bf2f(lw[r >> 1] & 0xffffu)) * upw[r];
                    lg[j] = (fminf(y, 0.f) - __logf(1.f + __expf(-fabsf(y)))) * 0.0625f; kk[j] = a; qs[j] = bf2f(zq[j] >> 16) * qscale; }
                tot += lg[j]; }
            float b = 0.f, kt[16];
#pragma unroll
            for (int jj = 0; jj < 16; ++jj) { const int j = DIR ? 15 - jj : jj; b += lg[j];
                if (OUT) { QD[j * DKP + d] = (bf16_t)f2bf(qs[j] * __expf(b)); KD[j * DKP + d] = (bf16_t)f2bf(kk[j] * __expf(-b)); }
                kt[j] = kk[j] * __expf(tot - b); }
            u32x4 w0, w1; w0.x = pk2(kt[0], kt[1]); w0.y = pk2(kt[2], kt[3]); w0.z = pk2(kt[4], kt[5]); w0.w = pk2(kt[6], kt[7]);
            w1.x = pk2(kt[8], kt[9]); w1.y = pk2(kt[10], kt[11]); w1.z = pk2(kt[12], kt[13]); w1.w = pk2(kt[14], kt[15]);
            *(LAS u32x4*)(KTT + d * 16) = w0; *(LAS u32x4*)(KTT + d * 16 + 8) = w1;
            DEC[d] = __expf(tot); dsum += tot;
          }
          u32x4 v0, v1; v0.x = vp[0]; v0.y = vp[1]; v0.z = vp[2]; v0.w = vp[3]; v1.x = vp[4]; v1.y = vp[5]; v1.z = vp[6]; v1.w = vp[7];
          *(LAS u32x4*)(VT + ev * 16) = v0; *(LAS u32x4*)(VT + ev * 16 + 8) = v1; }
        __syncthreads();
        if (ssi < 3) GLA_LOADRAW(DIR ? 2 - ssi : ssi + 1);
        unsigned ogv[4][4]; f32x4 ofv[4], os[4];
        if (OUT && DIR == 1) {
#pragma unroll
            for (int kq = 0; kq < 4; ++kq)
#pragma unroll
                for (int r = 0; r < 4; ++r) { const size_t row = (size_t)(rowbase + ss * 64 + (3 - kq) * 16 + lq * 4 + r);
                    ogv[kq][r] = ogT[row * 256 + e0 + l15]; ofv[kq][r] = ofw[row * 512 + h * 128 + e0 + l15]; }
        }
#pragma unroll
        for (int kq = 0; kq < 4; ++kq) {
            const int kc = DIR ? 3 - kq : kq; const int r0 = rowbase + ss * 64 + kc * 16;
            LAS unsigned char* cb = lds + kc * GC_STRIDE;
            const LAS bf16_t* QD = (const LAS bf16_t*)cb; const LAS bf16_t* KD = (const LAS bf16_t*)(cb + GC_KD); const LAS bf16_t* KTT = (const LAS bf16_t*)(cb + GC_KTT);
            const LAS bf16_t* VT = (const LAS bf16_t*)(cb + GC_VT); const LAS float* DEC = (const LAS float*)(cb + GC_DEC);
            bf16x8 aq[NKS];
            const bf16x8 vt = lq < 2 ? *(const LAS bf16x8*)(VT + (e0 + l15) * 16 + lq * 8) : zero8;
            f32x4 o = {0.f, 0.f, 0.f, 0.f};
            if (OUT) {
                f32x4 att = {0.f, 0.f, 0.f, 0.f};
#pragma unroll
                for (int ks = 0; ks < NKS; ++ks) { aq[ks] = *(const LAS bf16x8*)(QD + l15 * DKP + ks * 32 + lq * 8);
                    const bf16x8 bk = *(const LAS bf16x8*)(KD + l15 * DKP + ks * 32 + lq * 8); att = MFMA16(aq[ks], bk, att); }
#pragma unroll
                for (int r = 0; r < 4; ++r) { const int i = lq * 4 + r; const bool keep = DIR ? (l15 >= i) : (l15 <= i); ATT[i * 16 + l15] = keep ? (bf16_t)f2bf(att[r]) : (bf16_t)0; }
                WAVE_LDS_FENCE();
                const bf16x8 aatt = lq < 2 ? *(const LAS bf16x8*)(ATT + l15 * 16 + lq * 8) : zero8;
                o = MFMA16(aatt, vt, o);
#pragma unroll
                for (int ks = 0; ks < NKS; ++ks) { const bf16x8 bst = *(const LAS bf16x8*)(STB + l15 * DKP + ks * 32 + lq * 8); o = MFMA16(aq[ks], bst, o); }
            }
#pragma unroll
            for (int nt = 0; nt < NNT; ++nt) { const bf16x8 bkt = lq < 2 ? *(const LAS bf16x8*)(KTT + (nt * 16 + l15) * 16 + lq * 8) : zero8;
                const float dec = DEC[nt * 16 + l15]; ST[nt] = MFMA16(vt, bkt, ST[nt] * dec); }
            if (OUT) {
                WAVE_LDS_FENCE();
#pragma unroll
                for (int nt = 0; nt < NNT; ++nt)
#pragma unroll
                    for (int r = 0; r < 4; ++r) STB[(lq * 4 + r) * DKP + nt * 16 + l15] = (bf16_t)f2bf(ST[nt][r]);
                if (DIR == 0) {
#pragma unroll
                    for (int r = 0; r < 4; ++r) ofw[(size_t)(r0 + lq * 4 + r) * 512 + h * 128 + e0 + l15] = o[r];
                } else {
                    os[kq] = o + ofv[kq];
#pragma unroll
                    for (int r = 0; r < 4; ++r) { float v = os[kq][r] * os[kq][r]; v += __shfl_xor(v, 1); v += __shfl_xor(v, 2); v += __shfl_xor(v, 4); v += __shfl_xor(v, 8);
                        if (l15 == 0) SSQ[(kq * 16 + lq * 4 + r) * 8 + wid] = v; }
                }
            }
        }
        __syncthreads();
        if (OUT && DIR == 1) {
#pragma unroll
            for (int kq = 0; kq < 4; ++kq)
#pragma unroll
                for (int r = 0; r < 4; ++r) { const int i = lq * 4 + r; const size_t row = (size_t)(rowbase + ss * 64 + (3 - kq) * 16 + i);
                    const f32x4 a = *(const LAS f32x4*)(SSQ + (kq * 16 + i) * 8), b = *(const LAS f32x4*)(SSQ + (kq * 16 + i) * 8 + 4);
                    const float tot = (a[0] + a[1]) + (a[2] + a[3]) + (b[0] + b[1]) + (b[2] + b[3]); const float rs = rsqrtf(tot * (1.0f / 128.0f) + EPS);
                    const float og = bf2f(ogv[kq][r]); const float val = os[kq][r] * rs * nw * og * sigmoidf_(og);
                    oout[row * 512 + h * 128 + e0 + l15] = (bf16_t)f2bf(val); }
        }
    }
#undef GLA_LOADRAW
    if (!OUT) {
#pragma unroll
        for (int nt = 0; nt < NNT; ++nt)
#pragma unroll
            for (int r = 0; r < 4; ++r) Sg[(size_t)(e0 + lq * 4 + r) * DK + nt * 16 + l15] = ST[nt][r];
        if (prepqk) DSUM[ck * 128 + d] = dsum;
        __syncthreads();
        if (tid < DK) Dg[tid] = __expf((DSUM[tid] + DSUM[128 + tid]) + (DSUM[256 + tid] + DSUM[384 + tid]));
    }
    __syncthreads();
}
template <bool ISA, bool OUT>
__device__ __forceinline__ void gla_item(LAS unsigned char* lds, const Params& p, const int l, const int item) {
    gla_dir<ISA, OUT, 0>(lds, p, l, item);
    gla_dir<ISA, OUT, 1>(lds, p, l, item);
}

template <bool OUT>
__device__ __forceinline__ void rglru_item(LAS unsigned char* lds, const Params& p, const int l, const int item) {
    int tid_ = threadIdx.x; asm volatile("" : "+v"(tid_));
    const int tid = tid_, lane = tid & 63, w = __builtin_amdgcn_readfirstlane(tid >> 6);
    const int s = item >> 7, scc = item & 127, tb = scc * LCC;
    const int l15 = lane & 15, lq = lane >> 4, c = 64 * w + lane;
    unsigned char* ws = p.ws;
    const bf16_t* proj = (const bf16_t*)(ws + WS_PROJ);
    LAS bf16_t* XCS = (LAS bf16_t*)(lds + w * 10752); LAS float* AS = (LAS float*)(lds + w * 10752 + 2560); LAS float* US = (LAS float*)(lds + w * 10752 + 2560 + 4096);
    const bf16_t* xT = proj + (size_t)(16 + (w >> 2)) * PTILE + (w & 3) * 64 + lane;
    const bf16_t* yT = proj + (size_t)(18 + (w >> 2)) * PTILE + (w & 3) * 64 + lane;
    bf16_t* oc = (bf16_t*)(ws + WS_O) + (size_t)2 * MG * 512;
    float* CH = (float*)(ws + WS_CH); float* CP = (float*)(ws + WS_CP);
    const float cw0 = p.in[9][(l * 4 + 0) * 512 + c], cw1 = p.in[9][(l * 4 + 1) * 512 + c], cw2 = p.in[9][(l * 4 + 2) * 512 + c], cw3 = p.in[9][(l * 4 + 3) * 512 + c], cb = p.in[10][l * 512 + c];
#pragma unroll 1
    for (int dir = 0; dir < 2; ++dir) {
        bf16x8 wfa[4][2], wfx[4][2]; float ba[4], bx[4], sp[4];
        { const float* wa = p.in[11] + (size_t)((l * 2 + dir) * 8 + w) * 4096; const float* wx = p.in[13] + (size_t)((l * 2 + dir) * 8 + w) * 4096;
#pragma unroll
            for (int nt = 0; nt < 4; ++nt) {
#pragma unroll
                for (int ks = 0; ks < 2; ++ks)
#pragma unroll
                    for (int e = 0; e < 8; ++e) { const int k = ks * 32 + lq * 8 + e, j = nt * 16 + l15; wfa[nt][ks][e] = (short)f2bf(wa[k * 64 + j]); wfx[nt][ks][e] = (short)f2bf(wx[k * 64 + j]); }
                const int cj = (l * 2 + dir) * 512 + 64 * w + nt * 16 + l15;
                ba[nt] = p.in[12][cj]; bx[nt] = p.in[14][cj]; const float lam = p.in[15][cj];
                sp[nt] = fmaxf(-lam, 0.f) + __logf(1.f + __expf(-fabsf(lam)));
            } }
        const size_t cidx = ((size_t)(s * NCC + scc) * 2 + dir) * 512 + c;
        float hst = OUT ? CH[cidx] : 0.f, pprod = 1.f;
#pragma unroll 1
        for (int sbi = 0; sbi < 4; ++sbi) {
            const int sb = dir ? 3 - sbi : sbi, t0 = tb + 16 * sb;
            float xv[19];
#pragma unroll
            for (int i = 0; i < 19; ++i) { const int t = t0 - 2 + i; xv[i] = (t >= 0 && t < SEQ) ? bf2f(xT[(size_t)(s * SEQ + t) * 256]) : 0.f; }
#pragma unroll
            for (int i = 0; i < 16; ++i) XCS[i * 72 + lane] = (bf16_t)f2bf(cb + cw0 * xv[i] + cw1 * xv[i + 1] + cw2 * xv[i + 2] + cw3 * xv[i + 3]);
            WAVE_LDS_FENCE();
            f32x4 accr[4], acci[4];
            const bf16x8 af0 = *(const LAS bf16x8*)(XCS + l15 * 72 + lq * 8), af1 = *(const LAS bf16x8*)(XCS + l15 * 72 + 32 + lq * 8);
#pragma unroll
            for (int nt = 0; nt < 4; ++nt) { f32x4 z = {0.f, 0.f, 0.f, 0.f};
                accr[nt] = MFMA16(af0, wfa[nt][0], z); accr[nt] = MFMA16(af1, wfa[nt][1], accr[nt]);
                acci[nt] = MFMA16(af0, wfx[nt][0], z); acci[nt] = MFMA16(af1, wfx[nt][1], acci[nt]); }
#pragma unroll
            for (int nt = 0; nt < 4; ++nt)
#pragma unroll
                for (int r = 0; r < 4; ++r) { const int t = lq * 4 + r, jj = nt * 16 + l15;
                    const float rr = sigmoidf_(accr[nt][r] + ba[nt]), ii = sigmoidf_(acci[nt][r] + bx[nt]);
                    const float la = -8.0f * rr * sp[nt]; const float a = __expf(la); const float mult = sqrtf(fmaxf(-expm1f(2.0f * la), 0.f));
                    AS[t * 64 + jj] = a; US[t * 64 + jj] = mult * ii * bf2f(XCS[t * 72 + jj]); }
            WAVE_LDS_FENCE();
#pragma unroll
            for (int i2 = 0; i2 < 16; ++i2) { const int i = dir ? 15 - i2 : i2; const float a = AS[i * 64 + lane], u = US[i * 64 + lane];
                hst = a * hst + u; pprod *= a;
                if (OUT) { const size_t row = (size_t)(s * SEQ + t0 + i);
                    if (dir == 0) oc[row * 512 + c] = (bf16_t)f2bf(hst);
                    else { const float hf = bf2f(oc[row * 512 + c]); const float y = bf2f(yT[row * 256]); oc[row * 512 + c] = (bf16_t)f2bf((hf + hst) * gelu_tanh(y)); } } }
            WAVE_LDS_FENCE();
        }
        if (!OUT) { CH[cidx] = hst; CP[cidx] = pprod; }
    }
}

__device__ __forceinline__ void scan_phase(const Params& p) {
    unsigned char* ws = p.ws;
    int tid_ = threadIdx.x; asm volatile("" : "+v"(tid_));
    const int gtid = blockIdx.x * NTHR + tid_, nthr = gridDim.x * NTHR;
    constexpr int NA = GS * 4 * 2 * 128 * 128, NB = GS * 4 * 2 * 128 * 64;
    for (int idx = gtid; idx < NA + NB; idx += nthr) {
        const bool isa = idx < NA; const int i = isa ? idx : idx - NA; const int per = isa ? 16384 : 8192, dk = isa ? 128 : 64;
        const int shd = i / per, ed = i - shd * per, d = ed & (dk - 1), dir = shd & 1;
        float* S = (float*)(ws + (isa ? WS_SA : WS_SB)) + (size_t)shd * NSC * per + ed;
        const float* D = (const float*)(ws + (isa ? WS_DA : WS_DB)) + (size_t)shd * NSC * dk + d;
        float cur = 0.f;
#pragma unroll 1
        for (int q = 0; q < NSC; q += 8) {
            float tmp[8], dd[8];
#pragma unroll
            for (int k = 0; k < 8; ++k) { const int sc = dir ? NSC - 1 - (q + k) : q + k; tmp[k] = S[(size_t)sc * per]; dd[k] = D[(size_t)sc * dk]; }
#pragma unroll
            for (int k = 0; k < 8; ++k) { const int sc = dir ? NSC - 1 - (q + k) : q + k; S[(size_t)sc * per] = cur; cur = cur * dd[k] + tmp[k]; }
        }
    }
    if (gtid < GS * 2 * 512) {
        const int s = gtid >> 10, dir = (gtid >> 9) & 1, c = gtid & 511;
        float* CH = (float*)(ws + WS_CH); const float* CP = (const float*)(ws + WS_CP);
        float cur = 0.f;
#pragma unroll 1
        for (int q = 0; q < NCC; q += 8) {
            float tmp[8], dd[8];
#pragma unroll
            for (int k = 0; k < 8; ++k) { const int scc = dir ? NCC - 1 - (q + k) : q + k; const size_t ix = ((size_t)(s * NCC + scc) * 2 + dir) * 512 + c; tmp[k] = CH[ix]; dd[k] = CP[ix]; }
#pragma unroll
            for (int k = 0; k < 8; ++k) { const int scc = dir ? NCC - 1 - (q + k) : q + k; const size_t ix = ((size_t)(s * NCC + scc) * 2 + dir) * 512 + c; CH[ix] = cur; cur = cur * dd[k] + tmp[k]; }
        }
    }
}

__device__ __forceinline__ float bfe(const u32x4& v, int e) { const unsigned wd = (e >> 1) == 0 ? v.x : (e >> 1) == 1 ? v.y : (e >> 1) == 2 ? v.z : v.w; return (e & 1) ? bf2f(wd >> 16) : bf2f(wd & 0xffffu); }
__device__ __forceinline__ void convgelu_phase(const Params& p, const int l) {
    unsigned char* ws = p.ws;
    const bf16_t* u = (const bf16_t*)(ws + WS_PROJ); bf16_t* g = (bf16_t*)(ws + WS_O);
    int tid_ = threadIdx.x; asm volatile("" : "+v"(tid_));
    const int gtid = blockIdx.x * NTHR + tid_, nthr = gridDim.x * NTHR;
    const float* cw = p.in[20] + (size_t)l * 3 * 2 * DFF; const float* cbias = p.in[21] + (size_t)l * 2 * DFF;
    constexpr int NCG = DFF / 8, RUN = 16;
    for (int it = gtid; it < NCG * (MG / RUN); it += nthr) {
        const int cg8 = it % NCG, run = it / NCG, c = cg8 * 8, row0 = run * RUN, t0 = row0 & (SEQ - 1);
        float wg[3][8], wv[3][8], bg[8], bv[8];
#pragma unroll
        for (int j = 0; j < 3; ++j)
#pragma unroll
            for (int e = 0; e < 8; ++e) { wg[j][e] = cw[(size_t)j * 2 * DFF + c + e]; wv[j][e] = cw[(size_t)j * 2 * DFF + DFF + c + e]; }
#pragma unroll
        for (int e = 0; e < 8; ++e) { bg[e] = cbias[c + e]; bv[e] = cbias[DFF + c + e]; }
        const u32x4 z4 = {0, 0, 0, 0};
        u32x4 pg = z4, pv = z4, cg_, cv_;
        if (t0 > 0) { pg = *(const u32x4*)(u + (size_t)(row0 - 1) * (2 * DFF) + c); pv = *(const u32x4*)(u + (size_t)(row0 - 1) * (2 * DFF) + DFF + c); }
        cg_ = *(const u32x4*)(u + (size_t)row0 * (2 * DFF) + c); cv_ = *(const u32x4*)(u + (size_t)row0 * (2 * DFF) + DFF + c);
#pragma unroll 4
        for (int i = 0; i < RUN; ++i) {
            u32x4 ng = z4, nv = z4;
            if (t0 + i + 1 < SEQ) { ng = *(const u32x4*)(u + (size_t)(row0 + i + 1) * (2 * DFF) + c); nv = *(const u32x4*)(u + (size_t)(row0 + i + 1) * (2 * DFF) + DFF + c); }
            float o[8];
#pragma unroll
            for (int e = 0; e < 8; ++e) { const float a = bg[e] + wg[0][e] * bfe(pg, e) + wg[1][e] * bfe(cg_, e) + wg[2][e] * bfe(ng, e);
                const float b = bv[e] + wv[0][e] * bfe(pv, e) + wv[1][e] * bfe(cv_, e) + wv[2][e] * bfe(nv, e); o[e] = gelu_tanh(a) * b; }
            u32x4 w4; w4.x = pk2(o[0], o[1]); w4.y = pk2(o[2], o[3]); w4.z = pk2(o[4], o[5]); w4.w = pk2(o[6], o[7]);
            *(u32x4*)(g + (size_t)(row0 + i) * DFF + c) = w4;
            pg = cg_; pv = cv_; cg_ = ng; cv_ = nv;
        }
    }
}

#ifndef REP_M1
#define REP_M1 1
#endif
#ifndef REP_M3
#define REP_M3 1
#endif
#ifndef REP_G1
#define REP_G1 1
#endif
#ifndef REP_G5
#define REP_G5 1
#endif
__global__ void __launch_bounds__(NTHR, 2) mega_fwd(Params p) {
    extern __shared__ __attribute__((aligned(16))) unsigned char lds_raw[];
    LAS unsigned char* lds = (LAS unsigned char*)lds_raw;
    cg::grid_group grid = cg::this_grid();
    volatile LAS unsigned* bst = (volatile LAS unsigned*)(lds + 131072);
    if (threadIdx.x < 2) bst[threadIdx.x] = 0u;
    __syncthreads();
    const XcdBarrier bar = xcd_barrier_post((unsigned*)(p.ws + WS_BAR), bst);
    unsigned char* ws = p.ws;
    const int G = gridDim.x, bid = blockIdx.x;
    bf16_t* hbuf = (bf16_t*)(ws + WS_H);
    bf16_t* proj = (bf16_t*)(ws + WS_PROJ);

#pragma unroll 1
    for (int l = 0; l < DEPTH; ++l) {
#ifndef SKIP_CVT
        convert_phase(lds, p, l);
#endif
        if (l == 0) grid.sync(); else xcd_barrier(bar);
#pragma unroll 1
        for (int grp = 0; grp < NGRP; ++grp) {
            float* xg = p.out + (size_t)grp * MG * DM;
            if (l == 0) { const float* src = (grp == 0) ? p.in[0] : p.in[1] + (size_t)(grp - 1) * MG * DM; norm_phase(src, xg, p.in[2] + l * DM, hbuf, MG); }
            else norm_phase(xg, nullptr, p.in[2] + l * DM, hbuf, MG);
            xcd_barrier(bar);
#ifndef SKIP_G1
            for (int rep = 0; rep < REP_G1; ++rep)
            { Gemm g{hbuf, (const bf16_t*)(ws + WS_WIN), MG, NINP, DM}; pg8::StaticOrder S; S.init(MG, NINP, G, bid);
              EpiStoreBf16 E{proj, 256, 1}; pg8::gemm_phase<EpiStoreBf16, pg8::StaticOrder>(lds, g, S, E); }
#endif
            xcd_barrier(bar);
            for (int rep = 0; rep < REP_M1; ++rep) for (int it = bid; it < 256; it += G) {
#ifndef SKIP_GLA1
                gla_item<true, false>(lds, p, l, it); gla_item<false, false>(lds, p, l, it);
#endif
#ifndef SKIP_RG1
                rglru_item<false>(lds, p, l, it);
#endif
                __syncthreads(); }
            xcd_barrier(bar);
#ifndef SKIP_SCAN
            scan_phase(p);
#endif
            xcd_barrier(bar);
            for (int rep = 0; rep < REP_M3; ++rep) for (int it = bid; it < 256; it += G) {
#ifndef SKIP_GLA3
                gla_item<true, true>(lds, p, l, it); gla_item<false, true>(lds, p, l, it);
#endif
#ifndef SKIP_RG3
                rglru_item<true>(lds, p, l, it);
#endif
                __syncthreads(); }
            xcd_barrier(bar);
#ifndef SKIP_G3
            { Gemm g{(const bf16_t*)(ws + WS_O), (const bf16_t*)(ws + WS_WB), 3 * MG, 3 * DM, 512}; BranchOrder S{MG / 256, G, bid};
              EpiGate E{proj, (float*)(ws + WS_PROJ), hbuf, MG / 256}; pg8::gemm_phase<EpiGate, BranchOrder>(lds, g, S, E); }
#endif
            xcd_barrier(bar);
#ifndef SKIP_G4
            { Gemm g{hbuf, (const bf16_t*)(ws + WS_WOUT), MG, DM, DM}; pg8::StaticOrder S; S.init(MG, DM, G, bid);
              EpiResid E{xg}; pg8::gemm_phase<EpiResid, pg8::StaticOrder>(lds, g, S, E); }
#endif
            xcd_barrier(bar);
            norm_phase(xg, nullptr, p.in[18] + l * DM, hbuf, MG);
            xcd_barrier(bar);
#ifndef SKIP_G5
            for (int rep = 0; rep < REP_G5; ++rep)
            { Gemm g{hbuf, (const bf16_t*)(ws + WS_WUP), MG, 2 * DFF, DM}; pg8::StaticOrder S; S.init(MG, 2 * DFF, G, bid);
              EpiStoreBf16 E{proj, 2 * DFF, 0}; pg8::gemm_phase<EpiStoreBf16, pg8::StaticOrder>(lds, g, S, E); }
#endif
            xcd_barrier(bar);
#ifndef SKIP_CONV
            convgelu_phase(p, l);
#endif
            xcd_barrier(bar);
#ifndef SKIP_G6
            { Gemm g{(const bf16_t*)(ws + WS_O), (const bf16_t*)(ws + WS_WDN), MG, DM, DFF}; pg8::StaticOrder S; S.init(MG, DM, G, bid);
              EpiResid E{xg}; pg8::gemm_phase<EpiResid, pg8::StaticOrder>(lds, g, S, E); }
#endif
            xcd_barrier(bar);
        }
    }
    final_norm_phase(p.out, p.in[23], NSEQ * SEQ);
}

extern "C" void kernel_launch(void* const* d_in, const int* in_sizes, int n_in, void* d_out, int out_size, void* d_ws, size_t ws_size, hipStream_t stream) {
    static int grid = 0;
    if (grid == 0) {
        if (n_in != 24 || ws_size < WS_END) { fprintf(stderr, "kernel_launch: need 24 inputs and %zu bytes of workspace (got %d, %zu)\n", (size_t)WS_END, n_in, ws_size); grid = -1; return; }
        int dev = 0, cus = 0, per_cu = 0;
        hipGetDevice(&dev); hipDeviceGetAttribute(&cus, hipDeviceAttributeMultiprocessorCount, dev);
        hipFuncSetAttribute((const void*)mega_fwd, hipFuncAttributeMaxDynamicSharedMemorySize, LDS_BYTES);
        hipOccupancyMaxActiveBlocksPerMultiprocessor(&per_cu, (const void*)mega_fwd, NTHR, LDS_BYTES);
        if (per_cu < 1) { fprintf(stderr, "kernel_launch: occupancy query says 0 blocks per CU\n"); per_cu = 1; }
        grid = cus;
        (void)hipGetLastError();
    }
    if (grid < 0) return;
    if (hipMemsetAsync((char*)d_ws + WS_BAR, 0, XCD_BAR_WORDS * 4, stream) != hipSuccess) { fprintf(stderr, "kernel_launch: memset of the barrier words failed\n"); return; }
    Params p{};
    for (int i = 0; i < 24; ++i) p.in[i] = (const float*)d_in[i];
    p.out = (float*)d_out; p.ws = (unsigned char*)d_ws;
    void* args[] = {&p};
    hipError_t e = hipLaunchCooperativeKernel((const void*)mega_fwd, dim3(grid), dim3(NTHR), args, LDS_BYTES, stream);
    if (e != hipSuccess) fprintf(stderr, "cooperative launch failed: %s (grid %d)\n", hipGetErrorString(e), grid);
}
```

```cpp
#include <hip/hip_runtime.h>
#include <hip/hip_cooperative_groups.h>
#include <cstdio>
namespace cg = cooperative_groups;

#define LAS __attribute__((address_space(3)))
typedef unsigned short bf16_t;
typedef short bf16x8 __attribute__((ext_vector_type(8)));
typedef float f32x4 __attribute__((ext_vector_type(4)));
typedef float f32x2 __attribute__((ext_vector_type(2)));
typedef unsigned u32x4 __attribute__((ext_vector_type(4)));
typedef unsigned u32x2 __attribute__((ext_vector_type(2)));

constexpr int DM = 1024, SEQ = 8192, NSEQ = 6, DEPTH = 4;
constexpr int GS = 2;
constexpr int MG = GS * SEQ;
constexpr int NGRP = NSEQ / GS;
constexpr int NIN = 8224, NINP = 8448;
constexpr int DFF = 2816;
constexpr int LSC = 256, NSC = SEQ / LSC;
constexpr int LCC = 64, NCC = SEQ / LCC;
constexpr int NTHR = 512;
constexpr int LDS_BYTES = 131072 + 256;
constexpr float EPS = 1e-6f;

constexpr size_t WS_WIN  = 0;
constexpr size_t WS_WB   = WS_WIN  + (size_t)NINP * DM * 2;
constexpr size_t WS_WOUT = WS_WB   + (size_t)3 * DM * 512 * 2;
constexpr size_t WS_WUP  = WS_WOUT + (size_t)DM * DM * 2;
constexpr size_t WS_WDN  = WS_WUP  + (size_t)2 * DFF * DM * 2;
constexpr size_t WS_H    = WS_WDN  + (size_t)DM * DFF * 2;
constexpr size_t WS_PROJ = WS_H    + (size_t)MG * DM * 2;
constexpr size_t PTILE   = (size_t)MG * 256;
constexpr size_t WS_O    = WS_PROJ + 33 * PTILE * 2;
constexpr size_t WS_SA   = WS_O    + (size_t)3 * MG * 512 * 2;
constexpr size_t WS_SB   = WS_SA   + (size_t)GS * 4 * 2 * NSC * 128 * 128 * 4;
constexpr size_t WS_DA   = WS_SB   + (size_t)GS * 4 * 2 * NSC * 128 * 64 * 4;
constexpr size_t WS_DB   = WS_DA   + (size_t)GS * 4 * 2 * NSC * 128 * 4;
constexpr size_t WS_CH   = WS_DB   + (size_t)GS * 4 * 2 * NSC * 64 * 4;
constexpr size_t WS_CP   = WS_CH   + (size_t)GS * NCC * 2 * 512 * 4;
constexpr size_t WS_BAR  = WS_CP   + (size_t)GS * NCC * 2 * 512 * 4;
constexpr size_t WS_END  = WS_BAR  + 16384;
static_assert((size_t)MG * 2 * DFF * 2 <= 33 * PTILE * 2, "u buffer fits the projection region");
static_assert((size_t)MG * DFF * 2 <= WS_DA - WS_O, "g buffer fits o + state region");

struct Params { const float* in[24]; float* out; unsigned char* ws; };

__device__ __forceinline__ float bf2f(unsigned b) { return __uint_as_float(b << 16); }
typedef __bf16 bf16v2_t __attribute__((ext_vector_type(2)));
__device__ __forceinline__ unsigned pk2(float lo, float hi) { const f32x2 f = {lo, hi}; const bf16v2_t v = __builtin_convertvector(f, bf16v2_t); return __builtin_bit_cast(unsigned, v); }
__device__ __forceinline__ unsigned f2bf(float f) { return pk2(f, f) & 0xffffu; }
__device__ __forceinline__ float sigmoidf_(float x) { return __builtin_amdgcn_rcpf(1.0f + __expf(-x)); }
__device__ __forceinline__ float gelu_tanh(float x) { const float t = 1.5957691216057308f * (x + 0.044715f * x * x * x); return x * __builtin_amdgcn_rcpf(1.0f + __expf(-t)); }
__device__ __forceinline__ float wave_sum(float v) {
#pragma unroll
    for (int o = 32; o >= 1; o >>= 1) v += __shfl_xor(v, o);
    return v;
}

namespace pg8 {
#define PG8_LAS __attribute__((address_space(3)))
typedef unsigned short bf16_t;
typedef short bf16x8 __attribute__((ext_vector_type(8)));
typedef float f32x4 __attribute__((ext_vector_type(4)));
typedef unsigned u32x4 __attribute__((ext_vector_type(4)));
constexpr int BM = 256, BK = 64, HALF = 128, HTB = HALF * BK * 2  , STAGE_BYTES = 8 * HTB, NXCD = 8, WGM = 8;

__host__ __device__ __forceinline__ int lds_byte(int r, int c) { const int st = (r >> 4) * 2 + (c >> 5), rr = r & 15, cc = c & 31, ob = rr * 64 + cc * 2; return st * 1024 + (ob ^ (((ob >> 9) & 1) << 5)); }
__host__ __device__ __forceinline__ void stage_rc(int b, int& R, int& C) { const int st = b / 1024, sb = b % 1024, swz = sb ^ (((sb >> 9) & 1) << 5); R = (st >> 1) * 16 + swz / 64; C = (st & 1) * 32 + (swz % 64) / 2; }
__host__ __device__ __forceinline__ int perm32(int rho) { const int n = rho >> 4, i = rho & 15; return 8 * (i >> 2) + 4 * n + (i & 3); }

struct Unit { int pm, pn; };
struct Gemm { const bf16_t* A; const bf16_t* Bt; int M, N, K; };

struct StaticOrder {
    int nM, nN, nwg, G, c;
    __host__ __device__ void init(int M, int N, int G_, int c_) { nM = M / BM; nN = N / BM; nwg = nM * nN; G = G_; c = c_; }
    __host__ __device__ bool next(int i, Unit& u) const {
        const long L = (long)i * G + c; if (L >= nwg) return false;
        int wgid = (int)L; { const int q = nwg / NXCD, r = nwg % NXCD, xcd = wgid % NXCD, off = wgid / NXCD; wgid = (xcd < r ? xcd * (q + 1) : r * (q + 1) + (xcd - r) * q) + off; }
        const int nig = WGM * nN, gid = wgid / nig, fm = gid * WGM, gsz = (nM - fm) < WGM ? (nM - fm) : WGM;
        u.pm = fm + ((wgid % nig) % gsz); u.pn = (wgid % nig) / gsz; return true;
    }
    __device__ __forceinline__ void a_ready(const Unit&) const {}
    __device__ __forceinline__ void done(const Unit&) const {}
};
__device__ __forceinline__ unsigned cvt_pk_bf16(float lo, float hi) { return ::pk2(lo, hi); }
typedef float f32x2 __attribute__((ext_vector_type(2)));
template <class Epi, class Sched>
__device__ __forceinline__ void gemm_phase(PG8_LAS unsigned char* lds, const Gemm g, const Sched& S, const Epi& E) {
    int tid_ = threadIdx.x; asm volatile("" : "+v"(tid_));
    const int tid = tid_, wid = __builtin_amdgcn_readfirstlane(tid >> 6), lane = tid & 63, wr = wid >> 2, wc = wid & 3, fr = lane & 15, fq = lane >> 4;
    int K_ = g.K; asm volatile("" : "+s"(K_));
    const int K = K_, nt = K / BK;
    unsigned voffA[2], voffB[2];
#pragma unroll
    for (int i = 0; i < 2; ++i) { int R, C; stage_rc(tid * 16 + i * 8192, R, C); const int Rb = Epi::PERM ? ((R & ~31) + perm32(R & 31)) : R;
        voffA[i] = (unsigned)(R * K + C) * 2u; voffB[i] = (unsigned)(Rb * K + C) * 2u; }
    const size_t kstep = (size_t)(BK * 2);
    const size_t hstep = (size_t)HALF * K * 2;
    const size_t tstep = 2 * hstep;
    const unsigned ldsw = (unsigned)wid * 1024u;
    const int aoff = lds_byte(wr * 64 + fr, fq * 8), boff = lds_byte(wc * 32 + fr, fq * 8);
#define PG8_SA(b, h) (((b) * 2 + (h)) * HTB)
#define PG8_SB(b, h) ((4 + (b) * 2 + (h)) * HTB)
#define PG8_STAGE(bufoff, gbase, voff) do { _Pragma("unroll") for (int _i = 0; _i < 2; ++_i) \
        __builtin_amdgcn_global_load_lds((const unsigned*)((const char*)(gbase) + (voff)[_i]), (PG8_LAS unsigned*)(lds + (bufoff) + ldsw + _i * 8192), 16, 0, 0); } while (0)
#define PG8_LDA(dst, b, h) do { _Pragma("unroll") for (int m = 0; m < 4; ++m) _Pragma("unroll") for (int k = 0; k < 2; ++k) dst[m][k] = *(const PG8_LAS bf16x8*)(lds + PG8_SA(b, h) + aoff + m * 2048 + k * 1024); } while (0)
#define PG8_LDB(dst, b, h) do { _Pragma("unroll") for (int n = 0; n < 2; ++n) _Pragma("unroll") for (int k = 0; k < 2; ++k) dst[n][k] = *(const PG8_LAS bf16x8*)(lds + PG8_SB(b, h) + boff + n * 2048 + k * 1024); } while (0)
#define PG8_MMA(ai, bj, At, Bt) do { __builtin_amdgcn_s_setprio(1); _Pragma("unroll") for (int m = 0; m < 4; ++m) _Pragma("unroll") for (int n = 0; n < 2; ++n) _Pragma("unroll") for (int k = 0; k < 2; ++k) \
        acc[ai][bj][m][n] = __builtin_amdgcn_mfma_f32_16x16x32_bf16(Bt[n][k], At[m][k], acc[ai][bj][m][n], 0, 0, 0); __builtin_amdgcn_s_setprio(0); } while (0)
#define PG8_WAIT_V(n) asm volatile("s_waitcnt vmcnt(" #n ")" ::: "memory")
#define PG8_WAIT_L(n) asm volatile("s_waitcnt lgkmcnt(" #n ")" ::: "memory")
#define PG8_BAR __builtin_amdgcn_s_barrier()
#define PG8_SCHED __builtin_amdgcn_sched_barrier(0)
    Unit cur, nxt; int ui = 0;
    if (!S.next(0, cur)) return;
    f32x4 acc[2][2][4][2];
#pragma unroll
    for (int a = 0; a < 2; ++a)
#pragma unroll
        for (int b = 0; b < 2; ++b)
#pragma unroll
            for (int m = 0; m < 4; ++m)
#pragma unroll
                for (int n = 0; n < 2; ++n) acc[a][b][m][n] = (f32x4){0.f, 0.f, 0.f, 0.f};
    bf16x8 At[4][2], B0[2][2], B1[2][2];
    const char* cA = (const char*)g.A + (size_t)cur.pm * tstep; const char* cB = (const char*)g.Bt + (size_t)cur.pn * tstep;
    S.a_ready(cur);
    PG8_STAGE(PG8_SB(0, 0), cB, voffB); PG8_STAGE(PG8_SA(0, 0), cA, voffA); PG8_STAGE(PG8_SB(0, 1), cB + hstep, voffB); PG8_STAGE(PG8_SA(0, 1), cA + hstep, voffA);
    if (wr == 1) PG8_BAR;
    PG8_WAIT_V(4); PG8_BAR;
    PG8_STAGE(PG8_SB(1, 0), cB + kstep, voffB); PG8_STAGE(PG8_SA(1, 0), cA + kstep, voffA); PG8_STAGE(PG8_SB(1, 1), cB + hstep + kstep, voffB);
    PG8_WAIT_V(6); PG8_BAR;
    for (;;) {
        const bool has_next = S.next(ui + 1, nxt);
        const char* nA = has_next ? (const char*)g.A + (size_t)nxt.pm * tstep : cA; const char* nB = has_next ? (const char*)g.Bt + (size_t)nxt.pn * tstep : cB;
#pragma unroll 1
        for (int t = 0; t < nt; t += 2) {
            const bool last = (t == nt - 2);
            const char* a1 = cA + (size_t)(t + 1) * kstep;
            const char* a2 = last ? nA : cA + (size_t)(t + 2) * kstep; const char* b2 = last ? nB : cB + (size_t)(t + 2) * kstep;
            const char* a3 = a2 + kstep; const char* b3 = b2 + kstep;
            if (last && has_next) S.a_ready(nxt);
            PG8_LDB(B0, 0, 0); PG8_SCHED; PG8_LDA(At, 0, 0); PG8_STAGE(PG8_SA(1, 1), a1 + hstep, voffA);
            PG8_WAIT_L(8); PG8_BAR; PG8_WAIT_L(0); PG8_MMA(0, 0, At, B0); PG8_BAR; PG8_SCHED;
            PG8_LDB(B1, 0, 1); PG8_STAGE(PG8_SB(0, 0), b2, voffB);
            PG8_BAR; PG8_WAIT_L(0); PG8_MMA(0, 1, At, B1); PG8_BAR;
            PG8_LDA(At, 0, 1); PG8_STAGE(PG8_SA(0, 0), a2, voffA);
            PG8_BAR; PG8_WAIT_L(0); PG8_MMA(1, 0, At, B0); PG8_BAR; PG8_SCHED;
            PG8_STAGE(PG8_SB(0, 1), b2 + hstep, voffB);
            PG8_WAIT_V(6); PG8_BAR; PG8_MMA(1, 1, At, B1); PG8_BAR;
            PG8_LDB(B0, 1, 0); PG8_SCHED; PG8_LDA(At, 1, 0); PG8_STAGE(PG8_SA(0, 1), a2 + hstep, voffA);
            PG8_WAIT_L(8); PG8_BAR; PG8_WAIT_L(0); PG8_MMA(0, 0, At, B0); PG8_BAR; PG8_SCHED;
            PG8_LDB(B1, 1, 1); PG8_STAGE(PG8_SB(1, 0), b3, voffB);
            PG8_BAR; PG8_WAIT_L(0); PG8_MMA(0, 1, At, B1); PG8_BAR;
            PG8_LDA(At, 1, 1); PG8_STAGE(PG8_SA(1, 0), a3, voffA);
            PG8_BAR; PG8_WAIT_L(0); PG8_MMA(1, 0, At, B0); PG8_BAR; PG8_SCHED;
            PG8_STAGE(PG8_SB(1, 1), b3 + hstep, voffB);
            PG8_WAIT_V(6); PG8_BAR; PG8_MMA(1, 1, At, B1); PG8_BAR;
        }
        if constexpr (!Epi::AFTER_DRAIN) { E(acc, cur, wr, wc, fr, fq); S.done(cur); }
        if (!has_next) break;
#pragma unroll
        for (int a = 0; a < 2; ++a)
#pragma unroll
            for (int b = 0; b < 2; ++b)
#pragma unroll
                for (int m = 0; m < 4; ++m)
#pragma unroll
                    for (int n = 0; n < 2; ++n) acc[a][b][m][n] = (f32x4){0.f, 0.f, 0.f, 0.f};
        cur = nxt; cA = nA; cB = nB; ++ui;
    }
    PG8_WAIT_V(0);
    if (wr == 0) PG8_BAR;
    PG8_BAR;
    if constexpr (Epi::AFTER_DRAIN) { E.fused(acc, cur, wr, wc, fr, fq, lds, wid, lane); S.done(cur); }
#undef PG8_SA
#undef PG8_SB
#undef PG8_STAGE
#undef PG8_LDA
#undef PG8_LDB
#undef PG8_MMA
#undef PG8_WAIT_V
#undef PG8_WAIT_L
#undef PG8_BAR
#undef PG8_SCHED
}
}
#define XB_TMO      128
#define XB_XCNT(j)  (256  + 64 * (j))
#define XB_XSUB(j)  (1280 + 64 * (j))
#define XB_XGEN(j)  (2304 + 64 * (j))
#define XB_TOP      3328
#define XB_TOPGEN   3392
#define XCD_BAR_WORDS 3456
#define XB_SPIN_CAP (1u << 18)

__device__ __forceinline__ unsigned xb_ld(unsigned* p)              { return __hip_atomic_load(p, __ATOMIC_RELAXED, __HIP_MEMORY_SCOPE_AGENT); }
__device__ __forceinline__ unsigned xb_add(unsigned* p, unsigned v) { return __hip_atomic_fetch_add(p, v, __ATOMIC_RELAXED, __HIP_MEMORY_SCOPE_AGENT); }
__device__ __forceinline__ unsigned xb_xcc_id() { return (unsigned)__builtin_amdgcn_s_getreg((3 << 11) | 20) & 0xFu; }
#define XB_SPIN(cond, bar) do { unsigned _sp = 0; while (cond) { __builtin_amdgcn_s_sleep(1); \
    if ((++_sp & 255u) == 0u) { if (xb_ld(&(bar)[XB_TMO])) break; if (_sp > XB_SPIN_CAP) { atomicAdd(&(bar)[XB_TMO], 1u); break; } } } } while (0)

struct XcdBarrier {
    unsigned* bar; unsigned x;
    volatile LAS unsigned* st;
};

__device__ __forceinline__ XcdBarrier xcd_barrier_post(unsigned* bar, volatile LAS unsigned* st) {
    XcdBarrier b; b.bar = bar; b.x = xb_xcc_id(); b.st = st;
    if (threadIdx.x == 0) (void)xb_add(&bar[XB_XCNT(b.x)], 1u);
    return b;
}
__device__ __forceinline__ void xcd_barrier_complete(unsigned* bar, unsigned x, unsigned& nloc, unsigned& nx) {
    const unsigned G = gridDim.x * gridDim.y * gridDim.z;
    unsigned sum, cnt, mine, sp = 0u;
    for (;;) {
        sum = 0u; cnt = 0u; mine = 0u;
#pragma unroll
        for (unsigned j = 0; j < 16; ++j) { const unsigned c = xb_ld(&bar[XB_XCNT(j)]); sum += c; cnt += (c > 0u) ? 1u : 0u; mine = (j == x) ? c : mine; }
        if (sum == G) break;
        __builtin_amdgcn_s_sleep(1);
        if ((++sp & 255u) == 0u) { if (xb_ld(&bar[XB_TMO])) break; if (sp > XB_SPIN_CAP) { atomicAdd(&bar[XB_TMO], 1u); break; } }
    }
    nloc = mine > 0u ? mine : 1u; nx = cnt > 0u ? cnt : 1u;
}

__device__ __forceinline__ void xcd_barrier(const XcdBarrier& b) {
    asm volatile("s_waitcnt vmcnt(0)" ::: "memory");
    __syncthreads();
    if (threadIdx.x == 0) {
        unsigned* bar = b.bar;
        __builtin_amdgcn_s_waitcnt(0);
        unsigned nloc = b.st[0], nx = b.st[1];
        if (nloc == 0u) { xcd_barrier_complete(bar, b.x, nloc, nx); b.st[0] = nloc; b.st[1] = nx; }
        const unsigned old = xb_add(&bar[XB_XSUB(b.x)], 1u);
        const unsigned gen = old / nloc;
        if (old + 1u == (gen + 1u) * nloc) {
            __builtin_amdgcn_fence(__ATOMIC_RELEASE, "agent");
            asm volatile("s_waitcnt vmcnt(0)" ::: "memory");
            const unsigned og = xb_add(&bar[XB_TOP], 1u);
            const unsigned tg = og / nx;
            if (og + 1u == (tg + 1u) * nx) xb_add(&bar[XB_TOPGEN], 1u);
            else XB_SPIN(xb_ld(&bar[XB_TOPGEN]) == tg, bar);
            __builtin_amdgcn_fence(__ATOMIC_ACQUIRE, "agent");
            xb_add(&bar[XB_XGEN(b.x)], 1u);
            asm volatile("s_waitcnt vmcnt(0)" ::: "memory");
        } else {
            XB_SPIN(xb_ld(&bar[XB_XGEN(b.x)]) == gen, bar);
            __builtin_amdgcn_fence(__ATOMIC_ACQUIRE, "agent");
            asm volatile("s_waitcnt vmcnt(0)" ::: "memory");
        }
    }
    __syncthreads();
}

using pg8::Unit; using pg8::Gemm;

struct EpiStoreBf16 {
    static constexpr bool PERM = true, AFTER_DRAIN = false;
    bf16_t* O; int ldc; int tile_major;
    __device__ __forceinline__ void operator()(const f32x4 (&acc)[2][2][4][2], const Unit& u, int wr, int wc, int fr, int fq) const {
        const int row0 = u.pm * 256 + wr * 64 + fr; bf16_t* base = O; int colt = u.pn * 256;
        if (tile_major) { base += (size_t)u.pn * PTILE; colt = 0; }
        const int col0 = colt + wc * 32 + 8 * fq;
#pragma unroll
        for (int ai = 0; ai < 2; ++ai)
#pragma unroll
            for (int m = 0; m < 4; ++m) { bf16_t* rowp = base + (size_t)(row0 + ai * 128 + m * 16) * ldc + col0;
#pragma unroll
                for (int bj = 0; bj < 2; ++bj) { const f32x4 v0 = acc[ai][bj][m][0], v1 = acc[ai][bj][m][1];
                    u32x4 w; w.x = pg8::cvt_pk_bf16(v0[0], v0[1]); w.y = pg8::cvt_pk_bf16(v0[2], v0[3]); w.z = pg8::cvt_pk_bf16(v1[0], v1[1]); w.w = pg8::cvt_pk_bf16(v1[2], v1[3]);
                    *(u32x4*)(rowp + bj * 128) = w; } }
    }
};
struct EpiGate {
    static constexpr bool PERM = false, AFTER_DRAIN = false;
    const bf16_t* proj; float* mtmp; bf16_t* mb; int nM;
    __device__ __forceinline__ void operator()(const f32x4 (&acc)[2][2][4][2], const Unit& u, int wr, int wc, int fr, int fq) const {
        const int b = u.pm / nM, pm = u.pm - b * nM, pn = u.pn & 3;
        const bf16_t* gt = proj + (size_t)(20 + 4 * b + pn) * PTILE;
        const int row0 = pm * 256 + wr * 64 + fr, colin = wc * 32 + 4 * fq;
#pragma unroll
        for (int ai = 0; ai < 2; ++ai)
#pragma unroll
            for (int m = 0; m < 4; ++m) { const int r = row0 + ai * 128 + m * 16;
#pragma unroll
                for (int bj = 0; bj < 2; ++bj)
#pragma unroll
                    for (int n = 0; n < 2; ++n) { const int cin = colin + bj * 128 + n * 16;
                        const u32x2 gw = *(const u32x2*)(gt + (size_t)r * 256 + cin);
                        f32x4 g; g[0] = sigmoidf_(bf2f(gw.x & 0xffffu)); g[1] = sigmoidf_(bf2f(gw.x >> 16)); g[2] = sigmoidf_(bf2f(gw.y & 0xffffu)); g[3] = sigmoidf_(bf2f(gw.y >> 16));
                        f32x4 v = acc[ai][bj][m][n] * g;
                        float* mp = mtmp + (size_t)r * 1024 + pn * 256 + cin;
                        if (b > 0) v += *(const f32x4*)mp;
                        if (b < 2) *(f32x4*)mp = v;
                        else { u32x2 w; w.x = pg8::cvt_pk_bf16(v[0], v[1]); w.y = pg8::cvt_pk_bf16(v[2], v[3]); *(u32x2*)(mb + (size_t)r * 1024 + pn * 256 + cin) = w; } } }
    }
};
struct EpiResid {
    static constexpr bool PERM = false, AFTER_DRAIN = false;
    float* x;
    __device__ __forceinline__ void operator()(const f32x4 (&acc)[2][2][4][2], const Unit& u, int wr, int wc, int fr, int fq) const {
        const int row0 = u.pm * 256 + wr * 64 + fr, col0 = u.pn * 256 + wc * 32 + 4 * fq;
#pragma unroll
        for (int ai = 0; ai < 2; ++ai)
#pragma unroll
            for (int m = 0; m < 4; ++m) { float* rowp = x + (size_t)(row0 + ai * 128 + m * 16) * 1024 + col0;
#pragma unroll
                for (int bj = 0; bj < 2; ++bj)
#pragma unroll
                    for (int n = 0; n < 2; ++n) { float* q = rowp + bj * 128 + n * 16; *(f32x4*)q = *(const f32x4*)q + acc[ai][bj][m][n]; } }
    }
};
struct BranchOrder {
    int nM, G, c;
    __device__ __forceinline__ bool next(int i, Unit& u) const {
        const int tile = c + (i / 3) * G, b = i % 3; if (tile >= nM * 4) return false;
        u.pm = b * nM + (tile >> 2); u.pn = b * 4 + (tile & 3); return true; }
    __device__ __forceinline__ void a_ready(const Unit&) const {}
    __device__ __forceinline__ void done(const Unit&) const {}
};

__device__ __forceinline__ void cvt_tile(const float* __restrict__ src, int ldsrc, int k0, int c0, int valid, bf16_t* __restrict__ dst, int lddst, int r0, LAS float* tile, int tid) {
    const int kk = tid >> 3, seg = (tid & 7) * 8;
    float4 a = make_float4(0.f, 0.f, 0.f, 0.f), b = a;
    if (seg + 8 <= valid) { const float4* p = (const float4*)(src + (size_t)(k0 + kk) * ldsrc + c0 + seg); a = p[0]; b = p[1]; }
    LAS float* t = tile + kk * 65 + seg;
    t[0] = a.x; t[1] = a.y; t[2] = a.z; t[3] = a.w; t[4] = b.x; t[5] = b.y; t[6] = b.z; t[7] = b.w;
    __syncthreads();
    const int n = tid >> 3, ks = (tid & 7) * 8;
    const LAS float* s = tile + ks * 65 + n;
    u32x4 w; w.x = pk2(s[0], s[65]); w.y = pk2(s[2 * 65], s[3 * 65]); w.z = pk2(s[4 * 65], s[5 * 65]); w.w = pk2(s[6 * 65], s[7 * 65]);
    *(u32x4*)(dst + (size_t)(r0 + n) * lddst + k0 + ks) = w;
    __syncthreads();
}
__device__ __forceinline__ void convert_phase(LAS unsigned char* lds, const Params& p, int l) {
    LAS float* tile = (LAS float*)lds; int tid_ = threadIdx.x; asm volatile("" : "+v"(tid_)); const int tid = tid_; unsigned char* ws = p.ws;
    for (int idx = blockIdx.x; idx < 4864; idx += gridDim.x) {
        int i = idx;
        if (i < 2112) { const int nb = i % 132, kb = i / 132, r0 = nb * 64; int c0, valid;
            if (r0 < 4096) { c0 = r0; valid = 64; } else if (r0 < 8192) { c0 = r0 + 32; valid = 64; } else if (r0 == 8192) { c0 = 4096; valid = 32; } else { c0 = 0; valid = 0; }
            cvt_tile(p.in[3] + (size_t)l * DM * NIN, NIN, kb * 64, c0, valid, (bf16_t*)(ws + WS_WIN), DM, r0, tile, tid); continue; }
        i -= 2112;
        if (i < 384) { const int b = i / 128, rem = i % 128, nb = rem % 16, kb = rem / 16;
            cvt_tile(p.in[16] + (size_t)(l * 3 + b) * 512 * DM, DM, kb * 64, nb * 64, 64, (bf16_t*)(ws + WS_WB) + (size_t)b * DM * 512, 512, nb * 64, tile, tid); continue; }
        i -= 384;
        if (i < 256) { const int nb = i % 16, kb = i / 16;
            cvt_tile(p.in[17] + (size_t)l * DM * DM, DM, kb * 64, nb * 64, 64, (bf16_t*)(ws + WS_WOUT), DM, nb * 64, tile, tid); continue; }
        i -= 256;
        if (i < 1408) { const int nb = i % 88, kb = i / 88;
            cvt_tile(p.in[19] + (size_t)l * DM * 2 * DFF, 2 * DFF, kb * 64, nb * 64, 64, (bf16_t*)(ws + WS_WUP), DM, nb * 64, tile, tid); continue; }
        i -= 1408;
        { const int nb = i % 16, kb = i / 16;
            cvt_tile(p.in[22] + (size_t)l * DFF * DM, DM, kb * 64, nb * 64, 64, (bf16_t*)(ws + WS_WDN), DFF, nb * 64, tile, tid); }
    }
}

__device__ __forceinline__ void norm_phase(const float* __restrict__ src, float* xcopy, const float* __restrict__ w, bf16_t* hb, int nrows) {
    int tid_ = threadIdx.x; asm volatile("" : "+v"(tid_));
    const int lane = tid_ & 63, wv = blockIdx.x * 8 + (tid_ >> 6), nwv = gridDim.x * 8;
    float4 wv4[4];
#pragma unroll
    for (int j = 0; j < 4; ++j) wv4[j] = ((const float4*)w)[lane + 64 * j];
    for (int row = wv; row < nrows; row += nwv) {
        const float4* pr = (const float4*)(src + (size_t)row * DM); float4 v[4]; float ss = 0.f;
#pragma unroll
        for (int j = 0; j < 4; ++j) { v[j] = pr[lane + 64 * j]; ss += v[j].x * v[j].x + v[j].y * v[j].y + v[j].z * v[j].z + v[j].w * v[j].w; }
        ss = wave_sum(ss); const float rs = rsqrtf(ss * (1.0f / DM) + EPS);
#pragma unroll
        for (int j = 0; j < 4; ++j) { u32x2 o; o.x = pk2(v[j].x * rs * wv4[j].x, v[j].y * rs * wv4[j].y); o.y = pk2(v[j].z * rs * wv4[j].z, v[j].w * rs * wv4[j].w);
            *(u32x2*)(hb + (size_t)row * DM + (lane + 64 * j) * 4) = o;
            if (xcopy) ((float4*)(xcopy + (size_t)row * DM))[lane + 64 * j] = v[j]; }
    }
}
__device__ __forceinline__ void final_norm_phase(float* x, const float* __restrict__ w, int nrows) {
    int tid_ = threadIdx.x; asm volatile("" : "+v"(tid_));
    const int lane = tid_ & 63, wv = blockIdx.x * 8 + (tid_ >> 6), nwv = gridDim.x * 8;
    float4 wv4[4];
#pragma unroll
    for (int j = 0; j < 4; ++j) wv4[j] = ((const float4*)w)[lane + 64 * j];
    for (int row = wv; row < nrows; row += nwv) {
        float4* pr = (float4*)(x + (size_t)row * DM); float4 v[4]; float ss = 0.f;
#pragma unroll
        for (int j = 0; j < 4; ++j) { v[j] = pr[lane + 64 * j]; ss += v[j].x * v[j].x + v[j].y * v[j].y + v[j].z * v[j].z + v[j].w * v[j].w; }
        ss = wave_sum(ss); const float rs = rsqrtf(ss * (1.0f / DM) + EPS);
#pragma unroll
        for (int j = 0; j < 4; ++j) pr[lane + 64 * j] = make_float4(v[j].x * rs * wv4[j].x, v[j].y * rs * wv4[j].y, v[j].z * rs * wv4[j].z, v[j].w * rs * wv4[j].w);
    }
}

#define WAVE_LDS_FENCE() asm volatile("s_waitcnt lgkmcnt(0)" ::: "memory")
#define MFMA16(a, b, c) __builtin_amdgcn_mfma_f32_16x16x32_bf16((a), (b), (c), 0, 0, 0)
constexpr int GC_STRIDE = 17408, GC_KD = 4352, GC_KTT = 8704, GC_VT = 12800, GC_DEC = 16896;
constexpr int GN_STB = 4 * GC_STRIDE, GN_ATT = GN_STB + 8 * 4352, GN_SSQ = GN_ATT + 8 * 512, GN_DSUM = GN_SSQ + 2048, GN_END = GN_DSUM + 2048;
static_assert(GN_END <= 131072, "GLA LDS map fits");

template <bool ISA, bool OUT, int DIR>
__device__ __forceinline__ void gla_dir(LAS unsigned char* lds, const Params& p, const int l, const int item) {
    constexpr int DK = ISA ? 128 : 64, DKP = 136, NKS = DK / 32, NNT = DK / 16;
    int tid_ = threadIdx.x; asm volatile("" : "+v"(tid_));
    const int tid = tid_, lane = tid & 63, wid = __builtin_amdgcn_readfirstlane(tid >> 6);
    const int s = item >> 7, h = (item >> 5) & 3, sc = item & 31;
    const int rowbase = s * SEQ + sc * LSC;
    const int l15 = lane & 15, lq = lane >> 4, e0 = wid * 16;
    const int ck = wid >> 1, hh = wid & 1;
    const bool prepqk = ISA || hh == 0;
    const int d = ISA ? hh * 64 + lane : lane, ev = hh * 64 + lane;
    unsigned char* ws = p.ws;
    const bf16_t* proj = (const bf16_t*)(ws + WS_PROJ);
    LAS bf16_t* STB = (LAS bf16_t*)(lds + GN_STB + wid * 4352); LAS bf16_t* ATT = (LAS bf16_t*)(lds + GN_ATT + wid * 512);
    LAS float* SSQ = (LAS float*)(lds + GN_SSQ); LAS float* DSUM = (LAS float*)(lds + GN_DSUM);
    const size_t hoff = (size_t)(h >> 1) * PTILE + (h & 1) * 128;
    const bf16_t* qT = ISA ? proj + hoff : proj + 10 * PTILE + h * 64;
    const bf16_t* vT = proj + (ISA ? 6 : 12) * PTILE + hoff;
    const bf16_t* ogT = proj + (ISA ? 8 : 14) * PTILE + hoff;
    const bf16_t* zT = ISA ? proj + (size_t)(2 + 2 * DIR) * PTILE + hoff : proj + 11 * PTILE + h * 64;
    const bf16_t* lrT = proj + 32 * PTILE + DIR * 16;
    const float qscale = ISA ? 0.08838834764831845f : 0.125f;
    float* ofw = (float*)(ws + WS_H);
    bf16_t* oout = (bf16_t*)(ws + WS_O) + (ISA ? (size_t)0 : (size_t)MG * 512);
    const float nw = (ISA ? p.in[5] : p.in[8])[l * 128 + e0 + l15];
    const bf16x8 zero8 = {0, 0, 0, 0, 0, 0, 0, 0};
    const int shd = (s * 4 + h) * 2 + DIR;
    float* Sg = (float*)(ws + (ISA ? WS_SA : WS_SB)) + ((size_t)shd * NSC + sc) * (size_t)(128 * DK);
    float* Dg = (float*)(ws + (ISA ? WS_DA : WS_DB)) + ((size_t)shd * NSC + sc) * DK;

    float lb = 0.f, upb = 0.f, upw[16];
    if (ISA) { const int c = h * 128 + d; float x[4], mx = -1e30f;
#pragma unroll
        for (int q = 0; q < 4; ++q) { x[q] = p.in[4][(q * 2 + DIR) * 512 + c]; mx = fmaxf(mx, x[q]); }
        float den = 0.f, num = 0.f;
#pragma unroll
        for (int q = 0; q < 4; ++q) { const float ex = __expf(x[q] - mx); den += ex; if (q >= 1 && q <= l) num += ex; }
        lb = num * __builtin_amdgcn_rcpf(den);
#pragma unroll
        for (int r = 0; r < 16; ++r) upw[r] = 0.f;
    } else {
#pragma unroll
        for (int r = 0; r < 16; ++r) upw[r] = p.in[6][(size_t)((l * 2 + DIR) * 16 + r) * 256 + h * 64 + d];
        upb = p.in[7][(l * 2 + DIR) * 256 + h * 64 + d];
    }
    f32x4 ST[NNT];
#pragma unroll
    for (int nt = 0; nt < NNT; ++nt)
#pragma unroll
        for (int r = 0; r < 4; ++r) ST[nt][r] = OUT ? Sg[(size_t)(e0 + lq * 4 + r) * DK + nt * 16 + l15] : 0.f;
    if (OUT) {
#pragma unroll
        for (int nt = 0; nt < NNT; ++nt)
#pragma unroll
            for (int r = 0; r < 4; ++r) STB[(lq * 4 + r) * DKP + nt * 16 + l15] = (bf16_t)f2bf(ST[nt][r]);
    }
    float dsum = 0.f;
    unsigned zq[16], vp[8];
#define GLA_LOADRAW(SS) do { const size_t rb_ = (size_t)(rowbase + (SS) * 64 + ck * 16) * 256; \
        _Pragma("unroll") for (int j = 0; j < 16; ++j) { const unsigned z_ = prepqk ? (unsigned)zT[rb_ + (size_t)j * 256 + d] : 0u; const unsigned q_ = (OUT && prepqk) ? (unsigned)qT[rb_ + (size_t)j * 256 + d] : 0u; zq[j] = z_ | (q_ << 16); } \
        _Pragma("unroll") for (int j = 0; j < 8; ++j) vp[j] = (unsigned)vT[rb_ + (size_t)(2 * j) * 256 + ev] | ((unsigned)vT[rb_ + (size_t)(2 * j + 1) * 256 + ev] << 16); } while (0)
    GLA_LOADRAW(DIR ? 3 : 0);
    __syncthreads();

#pragma unroll 1
    for (int ssi = 0; ssi < 4; ++ssi) {
        const int ss = DIR ? 3 - ssi : ssi;
        { LAS unsigned char* cb = lds + ck * GC_STRIDE;
          LAS bf16_t* QD = (LAS bf16_t*)cb; LAS bf16_t* KD = (LAS bf16_t*)(cb + GC_KD); LAS bf16_t* KTT = (LAS bf16_t*)(cb + GC_KTT); LAS bf16_t* VT = (LAS bf16_t*)(cb + GC_VT); LAS float* DEC = (LAS float*)(cb + GC_DEC);
          if (prepqk) {
            float lg[16], kk[16], qs[16], tot = 0.f;
            const size_t rb = (size_t)(rowbase + ss * 64 + ck * 16) * 256;
#pragma unroll
            for (int j = 0; j < 16; ++j) { const float a = bf2f(zq[j] & 0xffffu);
                if (ISA) { const float sg = sigmoidf_(a); lg[j] = __logf(lb + (1.f - lb) * sg); kk[j] = (1.f - lb) * (1.f - sg); const float q = bf2f(zq[j] >> 16); qs[j] = q * sigmoidf_(q) * qscale; }
                else { const u32x4 lo = *(const u32x4*)(lrT + rb + (size_t)j * 256), hi = *(const u32x4*)(lrT + rb + (size_t)j * 256 + 8);
                    const unsigned lw[8] = {lo.x, lo.y, lo.z, lo.w, hi.x, hi.y, hi.z, hi.w}; float y = upb;
#pragma unroll
                    for (int r = 0; r < 16; ++r) y += ((r & 1) ? bf2f(lw[r >> 1] >> 16) : bf2f(lw[r >> 1] & 0xffffu)) * upw[r];
                    lg[j] = (fminf(y, 0.f) - __logf(1.f + __expf(-fabsf(y)))) * 0.0625f; kk[j] = a; qs[j] = bf2f(zq[j] >> 16) * qscale; }
                tot += lg[j]; }
            float b = 0.f, kt[16];
#pragma unroll
            for (int jj = 0; jj < 16; ++jj) { const int j = DIR ? 15 - jj : jj; b += lg[j];
                if (OUT) { QD[j * DKP + d] = (bf16_t)f2bf(qs[j] * __expf(b)); KD[j * DKP + d] = (bf16_t)f2bf(kk[j] * __expf(-b)); }
                kt[j] = kk[j] * __expf(tot - b); }
            u32x4 w0, w1; w0.x = pk2(kt[0], kt[1]); w0.y = pk2(kt[2], kt[3]); w0.z = pk2(kt[4], kt[5]); w0.w = pk2(kt[6], kt[7]);
            w1.x = pk2(kt[8], kt[9]); w1.y = pk2(kt[10], kt[11]); w1.z = pk2(kt[12], kt[13]); w1.w = pk2(kt[14], kt[15]);
            *(LAS u32x4*)(KTT + d * 16) = w0; *(LAS u32x4*)(KTT + d * 16 + 8) = w1;
            DEC[d] = __expf(tot); dsum += tot;
          }
          u32x4 v0, v1; v0.x = vp[0]; v0.y = vp[1]; v0.z = vp[2]; v0.w = vp[3]; v1.x = vp[4]; v1.y = vp[5]; v1.z = vp[6]; v1.w = vp[7];
          *(LAS u32x4*)(VT + ev * 16) = v0; *(LAS u32x4*)(VT + ev * 16 + 8) = v1; }
        __syncthreads();
        if (ssi < 3) GLA_LOADRAW(DIR ? 2 - ssi : ssi + 1);
        unsigned ogv[4][4]; f32x4 ofv[4], os[4];
        if (OUT && DIR == 1) {
#pragma unroll
            for (int kq = 0; kq < 4; ++kq)
#pragma unroll
                for (int r = 0; r < 4; ++r) { const size_t row = (size_t)(rowbase + ss * 64 + (3 - kq) * 16 + lq * 4 + r);
                    ogv[kq][r] = ogT[row * 256 + e0 + l15]; ofv[kq][r] = ofw[row * 512 + h * 128 + e0 + l15]; }
        }
#pragma unroll
        for (int kq = 0; kq < 4; ++kq) {
            const int kc = DIR ? 3 - kq : kq; const int r0 = rowbase + ss * 64 + kc * 16;
            LAS unsigned char* cb = lds + kc * GC_STRIDE;
            const LAS bf16_t* QD = (const LAS bf16_t*)cb; const LAS bf16_t* KD = (const LAS bf16_t*)(cb + GC_KD); const LAS bf16_t* KTT = (const LAS bf16_t*)(cb + GC_KTT);
            const LAS bf16_t* VT = (const LAS bf16_t*)(cb + GC_VT); const LAS float* DEC = (const LAS float*)(cb + GC_DEC);
            bf16x8 aq[NKS];
            const bf16x8 vt = lq < 2 ? *(const LAS bf16x8*)(VT + (e0 + l15) * 16 + lq * 8) : zero8;
            f32x4 o = {0.f, 0.f, 0.f, 0.f};
            if (OUT) {
                f32x4 att = {0.f, 0.f, 0.f, 0.f};
#pragma unroll
                for (int ks = 0; ks < NKS; ++ks) { aq[ks] = *(const LAS bf16x8*)(QD + l15 * DKP + ks * 32 + lq * 8);
                    const bf16x8 bk = *(const LAS bf16x8*)(KD + l15 * DKP + ks * 32 + lq * 8); att = MFMA16(aq[ks], bk, att); }
#pragma unroll
                for (int r = 0; r < 4; ++r) { const int i = lq * 4 + r; const bool keep = DIR ? (l15 >= i) : (l15 <= i); ATT[i * 16 + l15] = keep ? (bf16_t)f2bf(att[r]) : (bf16_t)0; }
                WAVE_LDS_FENCE();
                const bf16x8 aatt = lq < 2 ? *(const LAS bf16x8*)(ATT + l15 * 16 + lq * 8) : zero8;
                o = MFMA16(aatt, vt, o);
#pragma unroll
                for (int ks = 0; ks < NKS; ++ks) { const bf16x8 bst = *(const LAS bf16x8*)(STB + l15 * DKP + ks * 32 + lq * 8); o = MFMA16(aq[ks], bst, o); }
            }
#pragma unroll
            for (int nt = 0; nt < NNT; ++nt) { const bf16x8 bkt = lq < 2 ? *(const LAS bf16x8*)(KTT + (nt * 16 + l15) * 16 + lq * 8) : zero8;
                const float dec = DEC[nt * 16 + l15]; ST[nt] = MFMA16(vt, bkt, ST[nt] * dec); }
            if (OUT) {
                WAVE_LDS_FENCE();
#pragma unroll
                for (int nt = 0; nt < NNT; ++nt)
#pragma unroll
                    for (int r = 0; r < 4; ++r) STB[(lq * 4 + r) * DKP + nt * 16 + l15] = (bf16_t)f2bf(ST[nt][r]);
                if (DIR == 0) {
#pragma unroll
                    for (int r = 0; r < 4; ++r) ofw[(size_t)(r0 + lq * 4 + r) * 512 + h * 128 + e0 + l15] = o[r];
                } else {
                    os[kq] = o + ofv[kq];
#pragma unroll
                    for (int r = 0; r < 4; ++r) { float v = os[kq][r] * os[kq][r]; v += __shfl_xor(v, 1); v += __shfl_xor(v, 2); v += __shfl_xor(v, 4); v += __shfl_xor(v, 8);
                        if (l15 == 0) SSQ[(kq * 16 + lq * 4 + r) * 8 + wid] = v; }
                }
            }
        }
        __syncthreads();
        if (OUT && DIR == 1) {
#pragma unroll
            for (int kq = 0; kq < 4; ++kq)
#pragma unroll
                for (int r = 0; r < 4; ++r) { const int i = lq * 4 + r; const size_t row = (size_t)(rowbase + ss * 64 + (3 - kq) * 16 + i);
                    const f32x4 a = *(const LAS f32x4*)(SSQ + (kq * 16 + i) * 8), b = *(const LAS f32x4*)(SSQ + (kq * 16 + i) * 8 + 4);
                    const float tot = (a[0] + a[1]) + (a[2] + a[3]) + (b[0] + b[1]) + (b[2] + b[3]); const float rs = rsqrtf(tot * (1.0f / 128.0f) + EPS);
                    const float og = bf2f(ogv[kq][r]); const float val = os[kq][r] * rs * nw * og * sigmoidf_(og);
                    oout[row * 512 + h * 128 + e0 + l15] = (bf16_t)f2bf(val); }
        }
    }
#undef GLA_LOADRAW
    if (!OUT) {
#pragma unroll
        for (int nt = 0; nt < NNT; ++nt)
#pragma unroll
            for (int r = 0; r < 4; ++r) Sg[(size_t)(e0 + lq * 4 + r) * DK + nt * 16 + l15] = ST[nt][r];
        if (prepqk) DSUM[ck * 128 + d] = dsum;
        __syncthreads();
        if (tid < DK) Dg[tid] = __expf((DSUM[tid] + DSUM[128 + tid]) + (DSUM[256 + tid] + DSUM[384 + tid]));
    }
    __syncthreads();
}
template <bool ISA, bool OUT>
__device__ __forceinline__ void gla_item(LAS unsigned char* lds, const Params& p, const int l, const int item) {
    gla_dir<ISA, OUT, 0>(lds, p, l, item);
    gla_dir<ISA, OUT, 1>(lds, p, l, item);
}

template <bool OUT>
__device__ __forceinline__ void rglru_item(LAS unsigned char* lds, const Params& p, const int l, const int item) {
    int tid_ = threadIdx.x; asm volatile("" : "+v"(tid_));
    const int tid = tid_, lane = tid & 63, w = __builtin_amdgcn_readfirstlane(tid >> 6);
    const int s = item >> 7, scc = item & 127, tb = scc * LCC;
    const int l15 = lane & 15, lq = lane >> 4, c = 64 * w + lane;
    unsigned char* ws = p.ws;
    const bf16_t* proj = (const bf16_t*)(ws + WS_PROJ);
    LAS bf16_t* XCS = (LAS bf16_t*)(lds + w * 10752); LAS float* AS = (LAS float*)(lds + w * 10752 + 2560); LAS float* US = (LAS float*)(lds + w * 10752 + 2560 + 4096);
    const bf16_t* xT = proj + (size_t)(16 + (w >> 2)) * PTILE + (w & 3) * 64 + lane;
    const bf16_t* yT = proj + (size_t)(18 + (w >> 2)) * PTILE + (w & 3) * 64 + lane;
    bf16_t* oc = (bf16_t*)(ws + WS_O) + (size_t)2 * MG * 512;
    float* CH = (float*)(ws + WS_CH); float* CP = (float*)(ws + WS_CP);
    const float cw0 = p.in[9][(l * 4 + 0) * 512 + c], cw1 = p.in[9][(l * 4 + 1) * 512 + c], cw2 = p.in[9][(l * 4 + 2) * 512 + c], cw3 = p.in[9][(l * 4 + 3) * 512 + c], cb = p.in[10][l * 512 + c];
#pragma unroll 1
    for (int dir = 0; dir < 2; ++dir) {
        bf16x8 wfa[4][2], wfx[4][2]; float ba[4], bx[4], sp[4];
        { const float* wa = p.in[11] + (size_t)((l * 2 + dir) * 8 + w) * 4096; const float* wx = p.in[13] + (size_t)((l * 2 + dir) * 8 + w) * 4096;
#pragma unroll
            for (int nt = 0; nt < 4; ++nt) {
#pragma unroll
                for (int ks = 0; ks < 2; ++ks)
#pragma unroll
                    for (int e = 0; e < 8; ++e) { const int k = ks * 32 + lq * 8 + e, j = nt * 16 + l15; wfa[nt][ks][e] = (short)f2bf(wa[k * 64 + j]); wfx[nt][ks][e] = (short)f2bf(wx[k * 64 + j]); }
                const int cj = (l * 2 + dir) * 512 + 64 * w + nt * 16 + l15;
                ba[nt] = p.in[12][cj]; bx[nt] = p.in[14][cj]; const float lam = p.in[15][cj];
                sp[nt] = fmaxf(-lam, 0.f) + __logf(1.f + __expf(-fabsf(lam)));
            } }
        const size_t cidx = ((size_t)(s * NCC + scc) * 2 + dir) * 512 + c;
        float hst = OUT ? CH[cidx] : 0.f, pprod = 1.f;
#pragma unroll 1
        for (int sbi = 0; sbi < 4; ++sbi) {
            const int sb = dir ? 3 - sbi : sbi, t0 = tb + 16 * sb;
            float xv[19];
#pragma unroll
            for (int i = 0; i < 19; ++i) { const int t = t0 - 2 + i; xv[i] = (t >= 0 && t < SEQ) ? bf2f(xT[(size_t)(s * SEQ + t) * 256]) : 0.f; }
#pragma unroll
            for (int i = 0; i < 16; ++i) XCS[i * 72 + lane] = (bf16_t)f2bf(cb + cw0 * xv[i] + cw1 * xv[i + 1] + cw2 * xv[i + 2] + cw3 * xv[i + 3]);
            WAVE_LDS_FENCE();
            f32x4 accr[4], acci[4];
            const bf16x8 af0 = *(const LAS bf16x8*)(XCS + l15 * 72 + lq * 8), af1 = *(const LAS bf16x8*)(XCS + l15 * 72 + 32 + lq * 8);
#pragma unroll
            for (int nt = 0; nt < 4; ++nt) { f32x4 z = {0.f, 0.f, 0.f, 0.f};
                accr[nt] = MFMA16(af0, wfa[nt][0], z); accr[nt] = MFMA16(af1, wfa[nt][1], accr[nt]);
                acci[nt] = MFMA16(af0, wfx[nt][0], z); acci[nt] = MFMA16(af1, wfx[nt][1], acci[nt]); }
#pragma unroll
            for (int nt = 0; nt < 4; ++nt)
#pragma unroll
                for (int r = 0; r < 4; ++r) { const int t = lq * 4 + r, jj = nt * 16 + l15;
                    const float rr = sigmoidf_(accr[nt][r] + ba[nt]), ii = sigmoidf_(acci[nt][r] + bx[nt]);
                    const float la = -8.0f * rr * sp[nt]; const float a = __expf(la); const float mult = __builtin_amdgcn_sqrtf(fmaxf(fmaf(-a, a, 1.0f), 0.f));
                    AS[t * 64 + jj] = a; US[t * 64 + jj] = mult * ii * bf2f(XCS[t * 72 + jj]); }
            WAVE_LDS_FENCE();
#pragma unroll
            for (int i2 = 0; i2 < 16; ++i2) { const int i = dir ? 15 - i2 : i2; const float a = AS[i * 64 + lane], u = US[i * 64 + lane];
                hst = a * hst + u; pprod *= a;
                if (OUT) { const size_t row = (size_t)(s * SEQ + t0 + i);
                    if (dir == 0) oc[row * 512 + c] = (bf16_t)f2bf(hst);
                    else { const float hf = bf2f(oc[row * 512 + c]); const float y = bf2f(yT[row * 256]); oc[row * 512 + c] = (bf16_t)f2bf((hf + hst) * gelu_tanh(y)); } } }
            WAVE_LDS_FENCE();
        }
        if (!OUT) { CH[cidx] = hst; CP[cidx] = pprod; }
    }
}

__device__ __forceinline__ void scan_phase(const Params& p) {
    unsigned char* ws = p.ws;
    int tid_ = threadIdx.x; asm volatile("" : "+v"(tid_));
    const int gtid = blockIdx.x * NTHR + tid_, nthr = gridDim.x * NTHR;
    constexpr int NA = GS * 4 * 2 * 128 * 128, NB = GS * 4 * 2 * 128 * 64;
    for (int idx = gtid; idx < NA + NB; idx += nthr) {
        const bool isa = idx < NA; const int i = isa ? idx : idx - NA; const int per = isa ? 16384 : 8192, dk = isa ? 128 : 64;
        const int shd = i / per, ed = i - shd * per, d = ed & (dk - 1), dir = shd & 1;
        float* S = (float*)(ws + (isa ? WS_SA : WS_SB)) + (size_t)shd * NSC * per + ed;
        const float* D = (const float*)(ws + (isa ? WS_DA : WS_DB)) + (size_t)shd * NSC * dk + d;
        float cur = 0.f;
#pragma unroll 1
        for (int q = 0; q < NSC; q += 8) {
            float tmp[8], dd[8];
#pragma unroll
            for (int k = 0; k < 8; ++k) { const int sc = dir ? NSC - 1 - (q + k) : q + k; tmp[k] = S[(size_t)sc * per]; dd[k] = D[(size_t)sc * dk]; }
#pragma unroll
            for (int k = 0; k < 8; ++k) { const int sc = dir ? NSC - 1 - (q + k) : q + k; S[(size_t)sc * per] = cur; cur = cur * dd[k] + tmp[k]; }
        }
    }
    if (gtid < GS * 2 * 512) {
        const int s = gtid >> 10, dir = (gtid >> 9) & 1, c = gtid & 511;
        float* CH = (float*)(ws + WS_CH); const float* CP = (const float*)(ws + WS_CP);
        float cur = 0.f;
#pragma unroll 1
        for (int q = 0; q < NCC; q += 8) {
            float tmp[8], dd[8];
#pragma unroll
            for (int k = 0; k < 8; ++k) { const int scc = dir ? NCC - 1 - (q + k) : q + k; const size_t ix = ((size_t)(s * NCC + scc) * 2 + dir) * 512 + c; tmp[k] = CH[ix]; dd[k] = CP[ix]; }
#pragma unroll
            for (int k = 0; k < 8; ++k) { const int scc = dir ? NCC - 1 - (q + k) : q + k; const size_t ix = ((size_t)(s * NCC + scc) * 2 + dir) * 512 + c; CH[ix] = cur; cur = cur * dd[k] + tmp[k]; }
        }
    }
}

__device__ __forceinline__ float bfe(const u32x4& v, int e) { const unsigned wd = (e >> 1) == 0 ? v.x : (e >> 1) == 1 ? v.y : (e >> 1) == 2 ? v.z : v.w; return (e & 1) ? bf2f(wd >> 16) : bf2f(wd & 0xffffu); }
__device__ __forceinline__ void convgelu_phase(const Params& p, const int l) {
    unsigned char* ws = p.ws;
    const bf16_t* u = (const bf16_t*)(ws + WS_PROJ); bf16_t* g = (bf16_t*)(ws + WS_O);
    int tid_ = threadIdx.x; asm volatile("" : "+v"(tid_));
    const int gtid = blockIdx.x * NTHR + tid_, nthr = gridDim.x * NTHR;
    const float* cw = p.in[20] + (size_t)l * 3 * 2 * DFF; const float* cbias = p.in[21] + (size_t)l * 2 * DFF;
    constexpr int NCG = DFF / 8, RUN = 16;
    for (int it = gtid; it < NCG * (MG / RUN); it += nthr) {
        const int cg8 = it % NCG, run = it / NCG, c = cg8 * 8, row0 = run * RUN, t0 = row0 & (SEQ - 1);
        float wg[3][8], wv[3][8], bg[8], bv[8];
#pragma unroll
        for (int j = 0; j < 3; ++j)
#pragma unroll
            for (int e = 0; e < 8; ++e) { wg[j][e] = cw[(size_t)j * 2 * DFF + c + e]; wv[j][e] = cw[(size_t)j * 2 * DFF + DFF + c + e]; }
#pragma unroll
        for (int e = 0; e < 8; ++e) { bg[e] = cbias[c + e]; bv[e] = cbias[DFF + c + e]; }
        const u32x4 z4 = {0, 0, 0, 0};
        u32x4 pg = z4, pv = z4, cg_, cv_;
        if (t0 > 0) { pg = *(const u32x4*)(u + (size_t)(row0 - 1) * (2 * DFF) + c); pv = *(const u32x4*)(u + (size_t)(row0 - 1) * (2 * DFF) + DFF + c); }
        cg_ = *(const u32x4*)(u + (size_t)row0 * (2 * DFF) + c); cv_ = *(const u32x4*)(u + (size_t)row0 * (2 * DFF) + DFF + c);
#pragma unroll 4
        for (int i = 0; i < RUN; ++i) {
            u32x4 ng = z4, nv = z4;
            if (t0 + i + 1 < SEQ) { ng = *(const u32x4*)(u + (size_t)(row0 + i + 1) * (2 * DFF) + c); nv = *(const u32x4*)(u + (size_t)(row0 + i + 1) * (2 * DFF) + DFF + c); }
            float o[8];
#pragma unroll
            for (int e = 0; e < 8; ++e) { const float a = bg[e] + wg[0][e] * bfe(pg, e) + wg[1][e] * bfe(cg_, e) + wg[2][e] * bfe(ng, e);
                const float b = bv[e] + wv[0][e] * bfe(pv, e) + wv[1][e] * bfe(cv_, e) + wv[2][e] * bfe(nv, e); o[e] = gelu_tanh(a) * b; }
            u32x4 w4; w4.x = pk2(o[0], o[1]); w4.y = pk2(o[2], o[3]); w4.z = pk2(o[4], o[5]); w4.w = pk2(o[6], o[7]);
            *(u32x4*)(g + (size_t)(row0 + i) * DFF + c) = w4;
            pg = cg_; pv = cv_; cg_ = ng; cv_ = nv;
        }
    }
}

#ifndef REP_M1
#define REP_M1 1
#endif
#ifndef REP_M3
#define REP_M3 1
#endif
#ifndef REP_RG
#define REP_RG 1
#endif
#ifndef REP_G1
#define REP_G1 1
#endif
#ifndef REP_G5
#define REP_G5 1
#endif
__global__ void __launch_bounds__(NTHR, 2) mega_fwd(Params p) {
    extern __shared__ __attribute__((aligned(16))) unsigned char lds_raw[];
    LAS unsigned char* lds = (LAS unsigned char*)lds_raw;
    cg::grid_group grid = cg::this_grid();
    volatile LAS unsigned* bst = (volatile LAS unsigned*)(lds + 131072);
    if (threadIdx.x < 2) bst[threadIdx.x] = 0u;
    __syncthreads();
    const XcdBarrier bar = xcd_barrier_post((unsigned*)(p.ws + WS_BAR), bst);
    unsigned char* ws = p.ws;
    const int G = gridDim.x, bid = blockIdx.x;
    bf16_t* hbuf = (bf16_t*)(ws + WS_H);
    bf16_t* proj = (bf16_t*)(ws + WS_PROJ);

#pragma unroll 1
    for (int l = 0; l < DEPTH; ++l) {
#ifndef SKIP_CVT
        convert_phase(lds, p, l);
#endif
        if (l == 0) grid.sync(); else xcd_barrier(bar);
#pragma unroll 1
        for (int grp = 0; grp < NGRP; ++grp) {
            float* xg = p.out + (size_t)grp * MG * DM;
            if (l == 0) { const float* src = (grp == 0) ? p.in[0] : p.in[1] + (size_t)(grp - 1) * MG * DM; norm_phase(src, xg, p.in[2] + l * DM, hbuf, MG); }
            else norm_phase(xg, nullptr, p.in[2] + l * DM, hbuf, MG);
            xcd_barrier(bar);
#ifndef SKIP_G1
            for (int rep = 0; rep < REP_G1; ++rep)
            { Gemm g{hbuf, (const bf16_t*)(ws + WS_WIN), MG, NINP, DM}; pg8::StaticOrder S; S.init(MG, NINP, G, bid);
              EpiStoreBf16 E{proj, 256, 1}; pg8::gemm_phase<EpiStoreBf16, pg8::StaticOrder>(lds, g, S, E); }
#endif
            xcd_barrier(bar);
            for (int rep = 0; rep < REP_M1; ++rep) for (int it = bid; it < 256; it += G) {
#ifndef SKIP_GLA1
                gla_item<true, false>(lds, p, l, it); gla_item<false, false>(lds, p, l, it);
#endif
#ifndef SKIP_RG1
                for (int rr = 0; rr < REP_RG; ++rr) rglru_item<false>(lds, p, l, it);
#endif
                __syncthreads(); }
            xcd_barrier(bar);
#ifndef SKIP_SCAN
            scan_phase(p);
#endif
            xcd_barrier(bar);
            for (int rep = 0; rep < REP_M3; ++rep) for (int it = bid; it < 256; it += G) {
#ifndef SKIP_GLA3
                gla_item<true, true>(lds, p, l, it); gla_item<false, true>(lds, p, l, it);
#endif
#ifndef SKIP_RG3
                for (int rr = 0; rr < REP_RG; ++rr) rglru_item<true>(lds, p, l, it);
#endif
                __syncthreads(); }
            xcd_barrier(bar);
#ifndef SKIP_G3
            { Gemm g{(const bf16_t*)(ws + WS_O), (const bf16_t*)(ws + WS_WB), 3 * MG, 3 * DM, 512}; BranchOrder S{MG / 256, G, bid};
              EpiGate E{proj, (float*)(ws + WS_PROJ), hbuf, MG / 256}; pg8::gemm_phase<EpiGate, BranchOrder>(lds, g, S, E); }
#endif
            xcd_barrier(bar);
#ifndef SKIP_G4
            { Gemm g{hbuf, (const bf16_t*)(ws + WS_WOUT), MG, DM, DM}; pg8::StaticOrder S; S.init(MG, DM, G, bid);
              EpiResid E{xg}; pg8::gemm_phase<EpiResid, pg8::StaticOrder>(lds, g, S, E); }
#endif
            xcd_barrier(bar);
            norm_phase(xg, nullptr, p.in[18] + l * DM, hbuf, MG);
            xcd_barrier(bar);
#ifndef SKIP_G5
            for (int rep = 0; rep < REP_G5; ++rep)
            { Gemm g{hbuf, (const bf16_t*)(ws + WS_WUP), MG, 2 * DFF, DM}; pg8::StaticOrder S; S.init(MG, 2 * DFF, G, bid);
              EpiStoreBf16 E{proj, 2 * DFF, 0}; pg8::gemm_phase<EpiStoreBf16, pg8::StaticOrder>(lds, g, S, E); }
#endif
            xcd_barrier(bar);
#ifndef SKIP_CONV
            convgelu_phase(p, l);
#endif
            xcd_barrier(bar);
#ifndef SKIP_G6
            { Gemm g{(const bf16_t*)(ws + WS_O), (const bf16_t*)(ws + WS_WDN), MG, DM, DFF}; pg8::StaticOrder S; S.init(MG, DM, G, bid);
              EpiResid E{xg}; pg8::gemm_phase<EpiResid, pg8::StaticOrder>(lds, g, S, E); }
#endif
            xcd_barrier(bar);
        }
    }
    final_norm_phase(p.out, p.in[23], NSEQ * SEQ);
}

extern "C" void kernel_launch(void* const* d_in, const int* in_sizes, int n_in, void* d_out, int out_size, void* d_ws, size_t ws_size, hipStream_t stream) {
    static int grid = 0;
    if (grid == 0) {
        if (n_in != 24 || ws_size < WS_END) { fprintf(stderr, "kernel_launch: need 24 inputs and %zu bytes of workspace (got %d, %zu)\n", (size_t)WS_END, n_in, ws_size); grid = -1; return; }
        int dev = 0, cus = 0, per_cu = 0;
        hipGetDevice(&dev); hipDeviceGetAttribute(&cus, hipDeviceAttributeMultiprocessorCount, dev);
        hipFuncSetAttribute((const void*)mega_fwd, hipFuncAttributeMaxDynamicSharedMemorySize, LDS_BYTES);
        hipOccupancyMaxActiveBlocksPerMultiprocessor(&per_cu, (const void*)mega_fwd, NTHR, LDS_BYTES);
        if (per_cu < 1) { fprintf(stderr, "kernel_launch: occupancy query says 0 blocks per CU\n"); per_cu = 1; }
        grid = cus;
        (void)hipGetLastError();
    }
    if (grid < 0) return;
    if (hipMemsetAsync((char*)d_ws + WS_BAR, 0, XCD_BAR_WORDS * 4, stream) != hipSuccess) { fprintf(stderr, "kernel_launch: memset of the barrier words failed\n"); return; }
    Params p{};
    for (int i = 0; i < 24; ++i) p.in[i] = (const float*)d_in[i];
    p.out = (float*)d_out; p.ws = (unsigned char*)d_ws;
    void* args[] = {&p};
    hipError_t e = hipLaunchCooperativeKernel((const void*)mega_fwd, dim3(grid), dim3(NTHR), args, LDS_BYTES, stream);
    if (e != hipSuccess) fprintf(stderr, "cooperative launch failed: %s (grid %d)\n", hipGetErrorString(e), grid);
}
```

```cpp
#include <hip/hip_runtime.h>
#include <hip/hip_cooperative_groups.h>
#include <cstdio>
namespace cg = cooperative_groups;

#define LAS __attribute__((address_space(3)))
typedef unsigned short bf16_t;
typedef short bf16x8 __attribute__((ext_vector_type(8)));
typedef float f32x4 __attribute__((ext_vector_type(4)));
typedef float f32x2 __attribute__((ext_vector_type(2)));
typedef unsigned u32x4 __attribute__((ext_vector_type(4)));
typedef unsigned u32x2 __attribute__((ext_vector_type(2)));

constexpr int DM = 1024, SEQ = 8192, NSEQ = 6, DEPTH = 4;
constexpr int GS = 2;
constexpr int MG = GS * SEQ;
constexpr int NGRP = NSEQ / GS;
constexpr int NIN = 8224, NINP = 8704;
constexpr int DFF = 2816;
constexpr int LSC = 512, NSC = SEQ / LSC;
constexpr int NSCA = 32;
constexpr int LCC = 64, NCC = SEQ / LCC;
constexpr int NTHR = 512;
constexpr int LDS_BYTES = 131072 + 256;
constexpr float EPS = 1e-6f;

constexpr size_t WS_WIN  = 0;
constexpr size_t WS_WB   = WS_WIN  + (size_t)NINP * DM * 2;
constexpr size_t WS_WOUT = WS_WB   + (size_t)3 * DM * 512 * 2;
constexpr size_t WS_WUP  = WS_WOUT + (size_t)DM * DM * 2;
constexpr size_t WS_WDN  = WS_WUP  + (size_t)2 * DFF * DM * 2;
constexpr size_t WS_H    = WS_WDN  + (size_t)DM * DFF * 2;
constexpr size_t WS_PROJ = WS_H    + (size_t)MG * DM * 2;
constexpr size_t PTILE   = (size_t)MG * 256;
constexpr size_t WS_O    = WS_PROJ + 34 * PTILE * 2;
constexpr size_t WS_SA   = WS_O    + (size_t)3 * MG * 512 * 2;
constexpr size_t WS_SB   = WS_SA   + (size_t)GS * 4 * 2 * NSCA * 128 * 128 * 4;
constexpr size_t WS_DA   = WS_SB   + (size_t)GS * 4 * 2 * NSCA * 128 * 64 * 4;
constexpr size_t WS_DB   = WS_DA   + (size_t)GS * 4 * 2 * NSCA * 128 * 4;
constexpr size_t WS_CH   = WS_DB   + (size_t)GS * 4 * 2 * NSCA * 64 * 4;
constexpr size_t WS_CP   = WS_CH   + (size_t)GS * NCC * 2 * 512 * 4;
constexpr size_t WS_BAR  = WS_CP   + (size_t)GS * NCC * 2 * 512 * 4;
constexpr size_t WS_RGW  = WS_BAR  + 16384;
constexpr size_t WS_OFB  = WS_RGW  + 262144;
constexpr size_t WS_END  = WS_OFB  + (size_t)MG * 512 * 4;
static_assert((size_t)MG * 2 * DFF * 2 <= 34 * PTILE * 2, "u buffer fits the projection region");
static_assert((size_t)MG * DFF * 2 <= WS_DA - WS_O, "g buffer fits o + state region");

struct Params { const float* in[24]; float* out; unsigned char* ws; };

__device__ __forceinline__ float bf2f(unsigned b) { return __uint_as_float(b << 16); }
typedef __bf16 bf16v2_t __attribute__((ext_vector_type(2)));
__device__ __forceinline__ unsigned pk2(float lo, float hi) { const f32x2 f = {lo, hi}; const bf16v2_t v = __builtin_convertvector(f, bf16v2_t); return __builtin_bit_cast(unsigned, v); }
__device__ __forceinline__ unsigned f2bf(float f) { return pk2(f, f) & 0xffffu; }
__device__ __forceinline__ float sigmoidf_(float x) { return __builtin_amdgcn_rcpf(1.0f + __expf(-x)); }
__device__ __forceinline__ float gelu_tanh(float x) { const float t = 1.5957691216057308f * (x + 0.044715f * x * x * x); return x * __builtin_amdgcn_rcpf(1.0f + __expf(-t)); }
__device__ __forceinline__ float wave_sum(float v) {
#pragma unroll
    for (int o = 32; o >= 1; o >>= 1) v += __shfl_xor(v, o);
    return v;
}

namespace pg8 {
#define PG8_LAS __attribute__((address_space(3)))
typedef unsigned short bf16_t;
typedef short bf16x8 __attribute__((ext_vector_type(8)));
typedef float f32x4 __attribute__((ext_vector_type(4)));
typedef unsigned u32x4 __attribute__((ext_vector_type(4)));
constexpr int BM = 256, BK = 64, HALF = 128, HTB = HALF * BK * 2  , STAGE_BYTES = 8 * HTB, NXCD = 8, WGM = 8;

__host__ __device__ __forceinline__ int lds_byte(int r, int c) { const int st = (r >> 4) * 2 + (c >> 5), rr = r & 15, cc = c & 31, ob = rr * 64 + cc * 2; return st * 1024 + (ob ^ (((ob >> 9) & 1) << 5)); }
__host__ __device__ __forceinline__ void stage_rc(int b, int& R, int& C) { const int st = b / 1024, sb = b % 1024, swz = sb ^ (((sb >> 9) & 1) << 5); R = (st >> 1) * 16 + swz / 64; C = (st & 1) * 32 + (swz % 64) / 2; }
__host__ __device__ __forceinline__ int perm32(int rho) { const int n = rho >> 4, i = rho & 15; return 8 * (i >> 2) + 4 * n + (i & 3); }

struct Unit { int pm, pn; };
struct Gemm { const bf16_t* A; const bf16_t* Bt; int M, N, K; };

struct StaticOrder {
    int nM, nN, nwg, G, c;
    __host__ __device__ void init(int M, int N, int G_, int c_) { nM = M / BM; nN = N / BM; nwg = nM * nN; G = G_; c = c_; }
    __host__ __device__ bool next(int i, Unit& u) const {
        const long L = (long)i * G + c; if (L >= nwg) return false;
        int wgid = (int)L; { const int q = nwg / NXCD, r = nwg % NXCD, xcd = wgid % NXCD, off = wgid / NXCD; wgid = (xcd < r ? xcd * (q + 1) : r * (q + 1) + (xcd - r) * q) + off; }
        const int nig = WGM * nN, gid = wgid / nig, fm = gid * WGM, gsz = (nM - fm) < WGM ? (nM - fm) : WGM;
        u.pm = fm + ((wgid % nig) % gsz); u.pn = (wgid % nig) / gsz; return true;
    }
    __device__ __forceinline__ void a_ready(const Unit&) const {}
    __device__ __forceinline__ void done(const Unit&) const {}
};
__device__ __forceinline__ unsigned cvt_pk_bf16(float lo, float hi) { return ::pk2(lo, hi); }
typedef float f32x2 __attribute__((ext_vector_type(2)));
template <class Epi, class Sched>
__device__ __forceinline__ void gemm_phase(PG8_LAS unsigned char* lds, const Gemm g, const Sched& S, const Epi& E) {
    int tid_ = threadIdx.x; asm volatile("" : "+v"(tid_));
    const int tid = tid_, wid = __builtin_amdgcn_readfirstlane(tid >> 6), lane = tid & 63, wr = wid >> 2, wc = wid & 3, fr = lane & 15, fq = lane >> 4;
    int K_ = g.K; asm volatile("" : "+s"(K_));
    const int K = K_, nt = K / BK;
    unsigned voffA[2], voffB[2];
#pragma unroll
    for (int i = 0; i < 2; ++i) { int R, C; stage_rc(tid * 16 + i * 8192, R, C); const int Rb = Epi::PERM ? ((R & ~31) + perm32(R & 31)) : R;
        voffA[i] = (unsigned)(R * K + C) * 2u; voffB[i] = (unsigned)(Rb * K + C) * 2u; }
    const size_t kstep = (size_t)(BK * 2);
    const size_t hstep = (size_t)HALF * K * 2;
    const size_t tstep = 2 * hstep;
    const unsigned ldsw = (unsigned)wid * 1024u;
    const int aoff = lds_byte(wr * 64 + fr, fq * 8), boff = lds_byte(wc * 32 + fr, fq * 8);
#define PG8_SA(b, h) (((b) * 2 + (h)) * HTB)
#define PG8_SB(b, h) ((4 + (b) * 2 + (h)) * HTB)
#define PG8_STAGE(bufoff, gbase, voff) do { _Pragma("unroll") for (int _i = 0; _i < 2; ++_i) \
        __builtin_amdgcn_global_load_lds((const unsigned*)((const char*)(gbase) + (voff)[_i]), (PG8_LAS unsigned*)(lds + (bufoff) + ldsw + _i * 8192), 16, 0, 0); } while (0)
#define PG8_LDA(dst, b, h) do { _Pragma("unroll") for (int m = 0; m < 4; ++m) _Pragma("unroll") for (int k = 0; k < 2; ++k) dst[m][k] = *(const PG8_LAS bf16x8*)(lds + PG8_SA(b, h) + aoff + m * 2048 + k * 1024); } while (0)
#define PG8_LDB(dst, b, h) do { _Pragma("unroll") for (int n = 0; n < 2; ++n) _Pragma("unroll") for (int k = 0; k < 2; ++k) dst[n][k] = *(const PG8_LAS bf16x8*)(lds + PG8_SB(b, h) + boff + n * 2048 + k * 1024); } while (0)
#define PG8_MMA(ai, bj, At, Bt) do { __builtin_amdgcn_s_setprio(1); _Pragma("unroll") for (int m = 0; m < 4; ++m) _Pragma("unroll") for (int n = 0; n < 2; ++n) _Pragma("unroll") for (int k = 0; k < 2; ++k) \
        acc[ai][bj][m][n] = __builtin_amdgcn_mfma_f32_16x16x32_bf16(Bt[n][k], At[m][k], acc[ai][bj][m][n], 0, 0, 0); __builtin_amdgcn_s_setprio(0); } while (0)
#define PG8_WAIT_V(n) asm volatile("s_waitcnt vmcnt(" #n ")" ::: "memory")
#define PG8_WAIT_L(n) asm volatile("s_waitcnt lgkmcnt(" #n ")" ::: "memory")
#define PG8_BAR __builtin_amdgcn_s_barrier()
#define PG8_SCHED __builtin_amdgcn_sched_barrier(0)
    Unit cur, nxt; int ui = 0;
    if (!S.next(0, cur)) return;
    f32x4 acc[2][2][4][2];
#pragma unroll
    for (int a = 0; a < 2; ++a)
#pragma unroll
        for (int b = 0; b < 2; ++b)
#pragma unroll
            for (int m = 0; m < 4; ++m)
#pragma unroll
                for (int n = 0; n < 2; ++n) acc[a][b][m][n] = (f32x4){0.f, 0.f, 0.f, 0.f};
    bf16x8 At[4][2], B0[2][2], B1[2][2];
    const char* cA = (const char*)g.A + (size_t)cur.pm * tstep; const char* cB = (const char*)g.Bt + (size_t)cur.pn * tstep;
    S.a_ready(cur);
    PG8_STAGE(PG8_SB(0, 0), cB, voffB); PG8_STAGE(PG8_SA(0, 0), cA, voffA); PG8_STAGE(PG8_SB(0, 1), cB + hstep, voffB); PG8_STAGE(PG8_SA(0, 1), cA + hstep, voffA);
    if (wr == 1) PG8_BAR;
    PG8_WAIT_V(4); PG8_BAR;
    PG8_STAGE(PG8_SB(1, 0), cB + kstep, voffB); PG8_STAGE(PG8_SA(1, 0), cA + kstep, voffA); PG8_STAGE(PG8_SB(1, 1), cB + hstep + kstep, voffB);
    PG8_WAIT_V(6); PG8_BAR;
    for (;;) {
        const bool has_next = S.next(ui + 1, nxt);
        const char* nA = has_next ? (const char*)g.A + (size_t)nxt.pm * tstep : cA; const char* nB = has_next ? (const char*)g.Bt + (size_t)nxt.pn * tstep : cB;
#pragma unroll 1
        for (int t = 0; t < nt; t += 2) {
            const bool last = (t == nt - 2);
            const char* a1 = cA + (size_t)(t + 1) * kstep;
            const char* a2 = last ? nA : cA + (size_t)(t + 2) * kstep; const char* b2 = last ? nB : cB + (size_t)(t + 2) * kstep;
            const char* a3 = a2 + kstep; const char* b3 = b2 + kstep;
            if (last && has_next) S.a_ready(nxt);
            PG8_LDB(B0, 0, 0); PG8_SCHED; PG8_LDA(At, 0, 0); PG8_STAGE(PG8_SA(1, 1), a1 + hstep, voffA);
            PG8_WAIT_L(8); PG8_BAR; PG8_WAIT_L(0); PG8_MMA(0, 0, At, B0); PG8_BAR; PG8_SCHED;
            PG8_LDB(B1, 0, 1); PG8_STAGE(PG8_SB(0, 0), b2, voffB);
            PG8_BAR; PG8_WAIT_L(0); PG8_MMA(0, 1, At, B1); PG8_BAR;
            PG8_LDA(At, 0, 1); PG8_STAGE(PG8_SA(0, 0), a2, voffA);
            PG8_BAR; PG8_WAIT_L(0); PG8_MMA(1, 0, At, B0); PG8_BAR; PG8_SCHED;
            PG8_STAGE(PG8_SB(0, 1), b2 + hstep, voffB);
            PG8_WAIT_V(6); PG8_BAR; PG8_MMA(1, 1, At, B1); PG8_BAR;
            PG8_LDB(B0, 1, 0); PG8_SCHED; PG8_LDA(At, 1, 0); PG8_STAGE(PG8_SA(0, 1), a2 + hstep, voffA);
            PG8_WAIT_L(8); PG8_BAR; PG8_WAIT_L(0); PG8_MMA(0, 0, At, B0); PG8_BAR; PG8_SCHED;
            PG8_LDB(B1, 1, 1); PG8_STAGE(PG8_SB(1, 0), b3, voffB);
            PG8_BAR; PG8_WAIT_L(0); PG8_MMA(0, 1, At, B1); PG8_BAR;
            PG8_LDA(At, 1, 1); PG8_STAGE(PG8_SA(1, 0), a3, voffA);
            PG8_BAR; PG8_WAIT_L(0); PG8_MMA(1, 0, At, B0); PG8_BAR; PG8_SCHED;
            PG8_STAGE(PG8_SB(1, 1), b3 + hstep, voffB);
            PG8_WAIT_V(6); PG8_BAR; PG8_MMA(1, 1, At, B1); PG8_BAR;
        }
        if constexpr (!Epi::AFTER_DRAIN) { E(acc, cur, wr, wc, fr, fq); S.done(cur); }
        if (!has_next) break;
        if constexpr (!Epi::KEEP_ACC)
#pragma unroll
        for (int a = 0; a < 2; ++a)
#pragma unroll
            for (int b = 0; b < 2; ++b)
#pragma unroll
                for (int m = 0; m < 4; ++m)
#pragma unroll
                    for (int n = 0; n < 2; ++n) acc[a][b][m][n] = (f32x4){0.f, 0.f, 0.f, 0.f};
        cur = nxt; cA = nA; cB = nB; ++ui;
    }
    PG8_WAIT_V(0);
    if (wr == 0) PG8_BAR;
    PG8_BAR;
    if constexpr (Epi::AFTER_DRAIN) { E.fused(acc, cur, wr, wc, fr, fq, lds, wid, lane); S.done(cur); }
#undef PG8_SA
#undef PG8_SB
#undef PG8_STAGE
#undef PG8_LDA
#undef PG8_LDB
#undef PG8_MMA
#undef PG8_WAIT_V
#undef PG8_WAIT_L
#undef PG8_BAR
#undef PG8_SCHED
}
}
#define XB_TMO      128
#define XB_XCNT(j)  (256  + 64 * (j))
#define XB_XSUB(j)  (1280 + 64 * (j))
#define XB_XGEN(j)  (2304 + 64 * (j))
#define XB_TOP      3328
#define XB_TOPGEN   3392
#define XCD_BAR_WORDS 3456
#define XB_SPIN_CAP (1u << 18)

__device__ __forceinline__ unsigned xb_ld(unsigned* p)              { return __hip_atomic_load(p, __ATOMIC_RELAXED, __HIP_MEMORY_SCOPE_AGENT); }
__device__ __forceinline__ unsigned xb_add(unsigned* p, unsigned v) { return __hip_atomic_fetch_add(p, v, __ATOMIC_RELAXED, __HIP_MEMORY_SCOPE_AGENT); }
__device__ __forceinline__ unsigned xb_xcc_id() { return (unsigned)__builtin_amdgcn_s_getreg((3 << 11) | 20) & 0xFu; }
#define XB_SPIN(cond, bar) do { unsigned _sp = 0; while (cond) { __builtin_amdgcn_s_sleep(1); \
    if ((++_sp & 255u) == 0u) { if (xb_ld(&(bar)[XB_TMO])) break; if (_sp > XB_SPIN_CAP) { atomicAdd(&(bar)[XB_TMO], 1u); break; } } } } while (0)

struct XcdBarrier {
    unsigned* bar; unsigned x;
    volatile LAS unsigned* st;
};

__device__ __forceinline__ XcdBarrier xcd_barrier_post(unsigned* bar, volatile LAS unsigned* st) {
    XcdBarrier b; b.bar = bar; b.x = xb_xcc_id(); b.st = st;
    if (threadIdx.x == 0) (void)xb_add(&bar[XB_XCNT(b.x)], 1u);
    return b;
}
__device__ __forceinline__ void xcd_barrier_complete(unsigned* bar, unsigned x, unsigned& nloc, unsigned& nx) {
    const unsigned G = gridDim.x * gridDim.y * gridDim.z;
    unsigned sum, cnt, mine, sp = 0u;
    for (;;) {
        sum = 0u; cnt = 0u; mine = 0u;
#pragma unroll
        for (unsigned j = 0; j < 16; ++j) { const unsigned c = xb_ld(&bar[XB_XCNT(j)]); sum += c; cnt += (c > 0u) ? 1u : 0u; mine = (j == x) ? c : mine; }
        if (sum == G) break;
        __builtin_amdgcn_s_sleep(1);
        if ((++sp & 255u) == 0u) { if (xb_ld(&bar[XB_TMO])) break; if (sp > XB_SPIN_CAP) { atomicAdd(&bar[XB_TMO], 1u); break; } }
    }
    nloc = mine > 0u ? mine : 1u; nx = cnt > 0u ? cnt : 1u;
}

__device__ __forceinline__ void xcd_barrier(const XcdBarrier& b) {
    asm volatile("s_waitcnt vmcnt(0)" ::: "memory");
    __syncthreads();
    if (threadIdx.x == 0) {
        unsigned* bar = b.bar;
        __builtin_amdgcn_s_waitcnt(0);
        unsigned nloc = b.st[0], nx = b.st[1];
        if (nloc == 0u) { xcd_barrier_complete(bar, b.x, nloc, nx); b.st[0] = nloc; b.st[1] = nx; }
        const unsigned old = xb_add(&bar[XB_XSUB(b.x)], 1u);
        const unsigned gen = old / nloc;
        if (old + 1u == (gen + 1u) * nloc) {
            __builtin_amdgcn_fence(__ATOMIC_RELEASE, "agent");
            asm volatile("s_waitcnt vmcnt(0)" ::: "memory");
            const unsigned og = xb_add(&bar[XB_TOP], 1u);
            const unsigned tg = og / nx;
            if (og + 1u == (tg + 1u) * nx) xb_add(&bar[XB_TOPGEN], 1u);
            else XB_SPIN(xb_ld(&bar[XB_TOPGEN]) == tg, bar);
            __builtin_amdgcn_fence(__ATOMIC_ACQUIRE, "agent");
            xb_add(&bar[XB_XGEN(b.x)], 1u);
            asm volatile("s_waitcnt vmcnt(0)" ::: "memory");
        } else {
            XB_SPIN(xb_ld(&bar[XB_XGEN(b.x)]) == gen, bar);
            __builtin_amdgcn_fence(__ATOMIC_ACQUIRE, "agent");
            asm volatile("s_waitcnt vmcnt(0)" ::: "memory");
        }
    }
    __syncthreads();
}

using pg8::Unit; using pg8::Gemm;

struct EpiStoreBf16 {
    static constexpr bool PERM = true, AFTER_DRAIN = false, KEEP_ACC = false;
    bf16_t* O; int ldc; int tile_major;
    __device__ __forceinline__ void operator()(const f32x4 (&acc)[2][2][4][2], const Unit& u, int wr, int wc, int fr, int fq) const {
        const int row0 = u.pm * 256 + wr * 64 + fr; bf16_t* base = O; int colt = u.pn * 256;
        if (tile_major) { base += (size_t)u.pn * PTILE; colt = 0; }
        const int col0 = colt + wc * 32 + 8 * fq;
#pragma unroll
        for (int ai = 0; ai < 2; ++ai)
#pragma unroll
            for (int m = 0; m < 4; ++m) { bf16_t* rowp = base + (size_t)(row0 + ai * 128 + m * 16) * ldc + col0;
#pragma unroll
                for (int bj = 0; bj < 2; ++bj) { const f32x4 v0 = acc[ai][bj][m][0], v1 = acc[ai][bj][m][1];
                    u32x4 w; w.x = pg8::cvt_pk_bf16(v0[0], v0[1]); w.y = pg8::cvt_pk_bf16(v0[2], v0[3]); w.z = pg8::cvt_pk_bf16(v1[0], v1[1]); w.w = pg8::cvt_pk_bf16(v1[2], v1[3]);
                    __builtin_nontemporal_store(w, (u32x4*)(rowp + bj * 128)); } }
    }
};
struct EpiGate {
    static constexpr bool PERM = false, AFTER_DRAIN = false, KEEP_ACC = true;
    const bf16_t* proj; bf16_t* mb; int nM;
    __device__ __forceinline__ void operator()(f32x4 (&acc)[2][2][4][2], const Unit& u, int wr, int wc, int fr, int fq) const {
        const int b = u.pm / nM, pm = u.pm - b * nM, pn = u.pn & 3;
        const bf16_t* gt = proj + (size_t)(20 + 4 * b + pn) * PTILE; const bf16_t* gt2 = gt + (b < 2 ? 4 * PTILE : (size_t)0);
        const int row0 = pm * 256 + wr * 64 + fr, colin = wc * 32 + 4 * fq;
#pragma unroll
        for (int ai = 0; ai < 2; ++ai) { u32x2 gw[4][2][2], hw[4][2][2];
#pragma unroll
            for (int m = 0; m < 4; ++m)
#pragma unroll
                for (int bj = 0; bj < 2; ++bj)
#pragma unroll
                    for (int n = 0; n < 2; ++n) { const size_t go = (size_t)(row0 + ai * 128 + m * 16) * 256 + colin + bj * 128 + n * 16;
                        gw[m][bj][n] = *(const u32x2*)(gt + go); hw[m][bj][n] = *(const u32x2*)(gt2 + go); }
#pragma unroll
            for (int m = 0; m < 4; ++m)
#pragma unroll
                for (int bj = 0; bj < 2; ++bj)
#pragma unroll
                    for (int n = 0; n < 2; ++n) { const int r = row0 + ai * 128 + m * 16, cin = colin + bj * 128 + n * 16; const u32x2 g = gw[m][bj][n], hh = hw[m][bj][n];
                        f32x4 f; f[0] = __builtin_amdgcn_rcpf(1.0f + __expf(-bf2f(g.x & 0xffffu))); f[1] = __builtin_amdgcn_rcpf(1.0f + __expf(-bf2f(g.x >> 16)));
                        f[2] = __builtin_amdgcn_rcpf(1.0f + __expf(-bf2f(g.y & 0xffffu))); f[3] = __builtin_amdgcn_rcpf(1.0f + __expf(-bf2f(g.y >> 16)));
                        if (b < 2) { f[0] *= 1.0f + __expf(-bf2f(hh.x & 0xffffu)); f[1] *= 1.0f + __expf(-bf2f(hh.x >> 16)); f[2] *= 1.0f + __expf(-bf2f(hh.y & 0xffffu)); f[3] *= 1.0f + __expf(-bf2f(hh.y >> 16)); }
                        const f32x4 v = acc[ai][bj][m][n] * f;
                        if (b < 2) acc[ai][bj][m][n] = v;
                        else { u32x2 w; w.x = pk2(v[0], v[1]); w.y = pk2(v[2], v[3]); *(u32x2*)(mb + (size_t)r * 1024 + pn * 256 + cin) = w; acc[ai][bj][m][n] = (f32x4){0.f, 0.f, 0.f, 0.f}; } }
            asm volatile("" ::: "memory"); }
    }
};
struct EpiResid {
    static constexpr bool PERM = false, AFTER_DRAIN = false, KEEP_ACC = false;
    float* x;
    __device__ __forceinline__ void operator()(const f32x4 (&acc)[2][2][4][2], const Unit& u, int wr, int wc, int fr, int fq) const {
        const int row0 = u.pm * 256 + wr * 64 + fr, col0 = u.pn * 256 + wc * 32 + 4 * fq;
#pragma unroll
        for (int ai = 0; ai < 2; ++ai) { f32x4 old[4][2][2];
#pragma unroll
            for (int m = 0; m < 4; ++m)
#pragma unroll
                for (int bj = 0; bj < 2; ++bj)
#pragma unroll
                    for (int n = 0; n < 2; ++n) old[m][bj][n] = *(const f32x4*)(x + (size_t)(row0 + ai * 128 + m * 16) * 1024 + col0 + bj * 128 + n * 16);
#pragma unroll
            for (int m = 0; m < 4; ++m)
#pragma unroll
                for (int bj = 0; bj < 2; ++bj)
#pragma unroll
                    for (int n = 0; n < 2; ++n) *(f32x4*)(x + (size_t)(row0 + ai * 128 + m * 16) * 1024 + col0 + bj * 128 + n * 16) = old[m][bj][n] + acc[ai][bj][m][n];
            asm volatile("" ::: "memory"); }
    }
};
struct BranchOrder {
    int nM, G, c;
    __device__ __forceinline__ bool next(int i, Unit& u) const {
        const int c8 = (G % 8 == 0) ? (c % 8) * (G / 8) + c / 8 : c;
        const int tile = c8 + (i / 3) * G, b = i % 3; if (tile >= nM * 4) return false;
        u.pm = b * nM + (tile >> 2); u.pn = b * 4 + (tile & 3); return true; }
    __device__ __forceinline__ void a_ready(const Unit&) const {}
    __device__ __forceinline__ void done(const Unit&) const {}
};

__device__ __forceinline__ void cvt_tile(const float* __restrict__ src, int ldsrc, int k0, int c0, int valid, bf16_t* __restrict__ dst, int lddst, int r0, LAS float* tile, int tid) {
    const int kk = tid >> 3, seg = (tid & 7) * 8;
    float4 a = make_float4(0.f, 0.f, 0.f, 0.f), b = a;
    if (seg + 8 <= valid) { const f32x4* p = (const f32x4*)(src + (size_t)(k0 + kk) * ldsrc + c0 + seg); const f32x4 a4 = __builtin_nontemporal_load(p), b4 = __builtin_nontemporal_load(p + 1);
        a = make_float4(a4[0], a4[1], a4[2], a4[3]); b = make_float4(b4[0], b4[1], b4[2], b4[3]); }
    LAS float* t = tile + kk * 65 + seg;
    t[0] = a.x; t[1] = a.y; t[2] = a.z; t[3] = a.w; t[4] = b.x; t[5] = b.y; t[6] = b.z; t[7] = b.w;
    __syncthreads();
    const int n = tid >> 3, ks = (tid & 7) * 8;
    const LAS float* s = tile + ks * 65 + n;
    u32x4 w; w.x = pk2(s[0], s[65]); w.y = pk2(s[2 * 65], s[3 * 65]); w.z = pk2(s[4 * 65], s[5 * 65]); w.w = pk2(s[6 * 65], s[7 * 65]);
    *(u32x4*)(dst + (size_t)(r0 + n) * lddst + k0 + ks) = w;
    __syncthreads();
}
__device__ __forceinline__ void cvt_tile_lr(const float* __restrict__ win_l, const float* __restrict__ upw_d, int dir, int k0, int c0, bf16_t* __restrict__ dst, int r0, LAS float* tile, int tid) {
    const int kk = tid >> 3, seg = (tid & 7) * 8;
    const float4* wr = (const float4*)(win_l + (size_t)(k0 + kk) * NIN + 4096 + dir * 16);
    const float4 w0 = wr[0], w1 = wr[1], w2 = wr[2], w3 = wr[3];
    const float wv[16] = {w0.x, w0.y, w0.z, w0.w, w1.x, w1.y, w1.z, w1.w, w2.x, w2.y, w2.z, w2.w, w3.x, w3.y, w3.z, w3.w};
    float o[8] = {0.f, 0.f, 0.f, 0.f, 0.f, 0.f, 0.f, 0.f};
#pragma unroll
    for (int r = 0; r < 16; ++r) { const float4* up = (const float4*)(upw_d + (size_t)r * 256 + c0 + seg); const float4 a = up[0], b = up[1];
        o[0] += wv[r] * a.x; o[1] += wv[r] * a.y; o[2] += wv[r] * a.z; o[3] += wv[r] * a.w; o[4] += wv[r] * b.x; o[5] += wv[r] * b.y; o[6] += wv[r] * b.z; o[7] += wv[r] * b.w; }
    LAS float* t = tile + kk * 65 + seg;
#pragma unroll
    for (int j = 0; j < 8; ++j) t[j] = o[j];
    __syncthreads();
    const int n = tid >> 3, ks = (tid & 7) * 8;
    const LAS float* s = tile + ks * 65 + n;
    u32x4 w; w.x = pk2(s[0], s[65]); w.y = pk2(s[2 * 65], s[3 * 65]); w.z = pk2(s[4 * 65], s[5 * 65]); w.w = pk2(s[6 * 65], s[7 * 65]);
    *(u32x4*)(dst + (size_t)(r0 + n) * DM + k0 + ks) = w;
    __syncthreads();
}
__device__ __forceinline__ void convert_phase(LAS unsigned char* lds, const Params& p, int l) {
    LAS float* tile = (LAS float*)lds; int tid_ = threadIdx.x; asm volatile("" : "+v"(tid_)); const int tid = tid_; unsigned char* ws = p.ws;
    for (int it = blockIdx.x * NTHR + tid; it < 16384; it += gridDim.x * NTHR) {
        const int lane = it & 63, ks = (it >> 6) & 1, nt = (it >> 7) & 3, mat = (it >> 9) & 1, w = (it >> 10) & 7, dir = it >> 13;
        const float* src = (mat ? p.in[13] : p.in[11]) + (size_t)((l * 2 + dir) * 8 + w) * 4096;
        float v[8];
#pragma unroll
        for (int e = 0; e < 8; ++e) v[e] = src[(ks * 32 + (lane >> 4) * 8 + e) * 64 + nt * 16 + (lane & 15)];
        u32x4 o; o.x = pk2(v[0], v[1]); o.y = pk2(v[2], v[3]); o.z = pk2(v[4], v[5]); o.w = pk2(v[6], v[7]);
        *(u32x4*)((bf16_t*)(ws + WS_RGW) + (size_t)it * 8) = o;
    }
    for (int idx = blockIdx.x; idx < 4928; idx += gridDim.x) {
        int i = idx;
        if (i < 2048) { const int nb = i % 128, kb = i / 128, r0 = nb * 64; const int c0 = (r0 < 4096) ? r0 : r0 + 32;
            cvt_tile(p.in[3] + (size_t)l * DM * NIN, NIN, kb * 64, c0, 64, (bf16_t*)(ws + WS_WIN), DM, r0, tile, tid); continue; }
        i -= 2048;
        if (i < 128) { const int dir = i >> 6, cb = (i >> 4) & 3, kb = i & 15;
            cvt_tile_lr(p.in[3] + (size_t)l * DM * NIN, p.in[6] + (size_t)(l * 2 + dir) * 16 * 256, dir, kb * 64, cb * 64, (bf16_t*)(ws + WS_WIN), 8192 + dir * 256 + cb * 64, tile, tid); continue; }
        i -= 128;
        if (i < 384) { const int b = i / 128, rem = i % 128, nb = rem % 16, kb = rem / 16;
            cvt_tile(p.in[16] + (size_t)(l * 3 + b) * 512 * DM, DM, kb * 64, nb * 64, 64, (bf16_t*)(ws + WS_WB) + (size_t)b * DM * 512, 512, nb * 64, tile, tid); continue; }
        i -= 384;
        if (i < 256) { const int nb = i % 16, kb = i / 16;
            cvt_tile(p.in[17] + (size_t)l * DM * DM, DM, kb * 64, nb * 64, 64, (bf16_t*)(ws + WS_WOUT), DM, nb * 64, tile, tid); continue; }
        i -= 256;
        if (i < 1408) { const int nb = i % 88, kb = i / 88;
            cvt_tile(p.in[19] + (size_t)l * DM * 2 * DFF, 2 * DFF, kb * 64, nb * 64, 64, (bf16_t*)(ws + WS_WUP), DM, nb * 64, tile, tid); continue; }
        i -= 1408;
        { const int nb = i % 16, kb = i / 16;
            cvt_tile(p.in[22] + (size_t)l * DFF * DM, DM, kb * 64, nb * 64, 64, (bf16_t*)(ws + WS_WDN), DFF, nb * 64, tile, tid); }
    }
}

__device__ __forceinline__ void norm_phase(const float* __restrict__ src, float* xcopy, const float* __restrict__ w, bf16_t* hb, int nrows) {
    int tid_ = threadIdx.x; asm volatile("" : "+v"(tid_));
    const int lane = tid_ & 63, wv = blockIdx.x * 8 + (tid_ >> 6), nwv = gridDim.x * 8;
    float4 wv4[4];
#pragma unroll
    for (int j = 0; j < 4; ++j) wv4[j] = ((const float4*)w)[lane + 64 * j];
    for (int row = wv; row < nrows; row += nwv) {
        const float4* pr = (const float4*)(src + (size_t)row * DM); float4 v[4]; float ss = 0.f;
#pragma unroll
        for (int j = 0; j < 4; ++j) { v[j] = pr[lane + 64 * j]; ss += v[j].x * v[j].x + v[j].y * v[j].y + v[j].z * v[j].z + v[j].w * v[j].w; }
        ss = wave_sum(ss); const float rs = rsqrtf(ss * (1.0f / DM) + EPS);
#pragma unroll
        for (int j = 0; j < 4; ++j) { u32x2 o; o.x = pk2(v[j].x * rs * wv4[j].x, v[j].y * rs * wv4[j].y); o.y = pk2(v[j].z * rs * wv4[j].z, v[j].w * rs * wv4[j].w);
            *(u32x2*)(hb + (size_t)row * DM + (lane + 64 * j) * 4) = o;
            if (xcopy) ((float4*)(xcopy + (size_t)row * DM))[lane + 64 * j] = v[j]; }
    }
}
__device__ __forceinline__ void final_norm_phase(float* x, const float* __restrict__ w, int nrows) {
    int tid_ = threadIdx.x; asm volatile("" : "+v"(tid_));
    const int lane = tid_ & 63, wv = blockIdx.x * 8 + (tid_ >> 6), nwv = gridDim.x * 8;
    float4 wv4[4];
#pragma unroll
    for (int j = 0; j < 4; ++j) wv4[j] = ((const float4*)w)[lane + 64 * j];
    for (int row = wv; row < nrows; row += nwv) {
        float4* pr = (float4*)(x + (size_t)row * DM); float4 v[4]; float ss = 0.f;
#pragma unroll
        for (int j = 0; j < 4; ++j) { v[j] = pr[lane + 64 * j]; ss += v[j].x * v[j].x + v[j].y * v[j].y + v[j].z * v[j].z + v[j].w * v[j].w; }
        ss = wave_sum(ss); const float rs = rsqrtf(ss * (1.0f / DM) + EPS);
#pragma unroll
        for (int j = 0; j < 4; ++j) pr[lane + 64 * j] = make_float4(v[j].x * rs * wv4[j].x, v[j].y * rs * wv4[j].y, v[j].z * rs * wv4[j].z, v[j].w * rs * wv4[j].w);
    }
}

__device__ __forceinline__ float row16_sum(float v) {
    v += __builtin_bit_cast(float, __builtin_amdgcn_update_dpp(0, __builtin_bit_cast(int, v), 0x128, 0xf, 0xf, false));
    v += __builtin_bit_cast(float, __builtin_amdgcn_update_dpp(0, __builtin_bit_cast(int, v), 0x124, 0xf, 0xf, false));
    v += __builtin_bit_cast(float, __builtin_amdgcn_update_dpp(0, __builtin_bit_cast(int, v), 0x122, 0xf, 0xf, false));
    v += __builtin_bit_cast(float, __builtin_amdgcn_update_dpp(0, __builtin_bit_cast(int, v), 0x121, 0xf, 0xf, false));
    return v;
}
#define WAVE_LDS_FENCE() asm volatile("" ::: "memory")
#define LDS_BARRIER() do { asm volatile("s_waitcnt lgkmcnt(0)" ::: "memory"); __builtin_amdgcn_s_barrier(); asm volatile("" ::: "memory"); } while (0)
#define MFMA16(a, b, c) __builtin_amdgcn_mfma_f32_16x16x32_bf16((a), (b), (c), 0, 0, 0)
typedef short bf16x4 __attribute__((ext_vector_type(4)));
#define MFMA16K16(a, b, c) __builtin_amdgcn_mfma_f32_16x16x16bf16_1k((a), (b), (c), 0, 0, 0)
constexpr int GC_STRIDE = 17408, GC_KD = 4352, GC_KTT = 8704, GC_VT = 12800, GC_DEC = 16896;
constexpr int GN_STB = 4 * GC_STRIDE, GN_ATT = GN_STB + 8 * 4352, GN_SSQ = GN_ATT + 8 * 512, GN_DSUM = GN_SSQ + 2048, GN_END = GN_DSUM + 2048;
static_assert(GN_END <= 131072, "GLA LDS map fits");

template <bool ISA, bool OUT>
__device__ __forceinline__ void gla_item(LAS unsigned char* lds, const Params& p, const int l, const int item, unsigned long long* tt) {
    constexpr int DK = ISA ? 128 : 64, DKP = 136, NKS = DK / 32, NNT = DK / 16;
    int tid_ = threadIdx.x; asm volatile("" : "+v"(tid_));
    const int tid = tid_, lane = tid & 63, wid = __builtin_amdgcn_readfirstlane(tid >> 6);
    const int s = item >> 6, h = (item >> 4) & 3, sc = item & 15;
    const int rowbase = s * SEQ + sc * LSC;
    const int l15 = lane & 15, lq = lane >> 4, e0 = wid * 16;
    const int ck = wid >> 1, hh = wid & 1;
    const bool prepqk = ISA || hh == 0;
    const int d = ISA ? hh * 64 + lane : lane, ev = hh * 64 + lane;
    unsigned char* ws = p.ws;
    const bf16_t* proj = (const bf16_t*)(ws + WS_PROJ);
    LAS bf16_t* STB = (LAS bf16_t*)(lds + GN_STB + wid * 4352); LAS bf16_t* ATT = (LAS bf16_t*)(lds + GN_ATT + wid * 512);
    LAS float* SSQ = (LAS float*)(lds + GN_SSQ); LAS float* DSUM = (LAS float*)(lds + GN_DSUM);
    const size_t hoff = (size_t)(h >> 1) * PTILE + (h & 1) * 128;
    const bf16_t* qT = ISA ? proj + hoff : proj + 10 * PTILE + h * 64;
    const bf16_t* vT = proj + (ISA ? 6 : 12) * PTILE + hoff;
    const bf16_t* ogT = proj + (ISA ? 8 : 14) * PTILE + hoff;
    const float qscale = ISA ? 0.08838834764831845f : 0.125f;
    float* ofw = (float*)(ws + (ISA ? WS_H : WS_OFB));
    bf16_t* oout = (bf16_t*)(ws + WS_O) + (ISA ? (size_t)0 : (size_t)MG * 512);
    const float nw = (ISA ? p.in[5] : p.in[8])[l * 128 + e0 + l15];
#pragma unroll 1
    for (int dir = 0; dir < 2; ++dir) {
    const bf16_t* zT = ISA ? proj + (size_t)(2 + 2 * dir) * PTILE + hoff : proj + 11 * PTILE + h * 64;
    const bf16_t* yT = proj + (size_t)(32 + dir) * PTILE + h * 64;
    const int shd = (s * 4 + h) * 2 + dir;
    float* Sg = (float*)(ws + (ISA ? WS_SA : WS_SB)) + ((size_t)shd * NSC + sc) * (size_t)(128 * DK);
    float* Dg = (float*)(ws + (ISA ? WS_DA : WS_DB)) + ((size_t)shd * NSC + sc) * DK;

    float lb = 0.f, upb = 0.f;
    if (ISA) { const int c = h * 128 + d; float x[4], mx = -1e30f;
#pragma unroll
        for (int q = 0; q < 4; ++q) { x[q] = p.in[4][(q * 2 + dir) * 512 + c]; mx = fmaxf(mx, x[q]); }
        float den = 0.f, num = 0.f;
#pragma unroll
        for (int q = 0; q < 4; ++q) { const float ex = __expf(x[q] - mx); den += ex; if (q >= 1 && q <= l) num += ex; }
        lb = num * __builtin_amdgcn_rcpf(den);
    } else upb = p.in[7][(l * 2 + dir) * 256 + h * 64 + d];
    f32x4 ST[NNT];
#pragma unroll
    for (int nt = 0; nt < NNT; ++nt)
#pragma unroll
        for (int r = 0; r < 4; ++r) ST[nt][r] = OUT ? Sg[(size_t)(e0 + lq * 4 + r) * DK + nt * 16 + l15] : 0.f;
    if (OUT) {
#pragma unroll
        for (int nt = 0; nt < NNT; ++nt)
#pragma unroll
            for (int r = 0; r < 4; ++r) STB[(lq * 4 + r) * DKP + nt * 16 + l15] = (bf16_t)f2bf(ST[nt][r]);
    }
    float dsum = 1.f;
    unsigned zr[16];
#define GLA_LOADRAW(SSI) do { const int pos0_ = (SSI) * 64 + ck * 16;     \
        _Pragma("unroll") for (int j = 0; j < 16; ++j) { const size_t ro_ = (size_t)(rowbase + (dir ? (LSC - 1) - (pos0_ + j) : pos0_ + j)) * 256; \
            zr[j] = (unsigned)zT[ro_ + d]; } \
        __builtin_amdgcn_sched_barrier(0); } while (0)
    GLA_LOADRAW(0);
    __syncthreads();

#pragma unroll 1
    for (int ssi = 0; ssi < LSC / 64; ++ssi) {
#ifdef PROBE_STAGES
        unsigned long long ts0 = __builtin_amdgcn_s_memrealtime();
#endif
        { LAS unsigned char* cb = lds + ck * GC_STRIDE;
          LAS bf16_t* QD = (LAS bf16_t*)cb; LAS bf16_t* KD = (LAS bf16_t*)(cb + GC_KD); LAS bf16_t* KTT = (LAS bf16_t*)(cb + GC_KTT); LAS bf16_t* VT = (LAS bf16_t*)(cb + GC_VT); LAS float* DEC = (LAS float*)(cb + GC_DEC);
          unsigned qr[16], vr[16], yr[16];
          { const int pos0_ = ssi * 64 + ck * 16;
#pragma unroll
            for (int j = 0; j < 16; ++j) { const size_t ro_ = (size_t)(rowbase + (dir ? (LSC - 1) - (pos0_ + j) : pos0_ + j)) * 256; qr[j] = OUT ? (unsigned)qT[ro_ + d] : 0u; yr[j] = ISA ? 0u : (unsigned)yT[ro_ + d]; }
            __builtin_amdgcn_sched_barrier(0); }
#define VLOAD() do { const int pv0_ = ssi * 64 + ck * 16; _Pragma("unroll") for (int j = 0; j < 16; ++j) vr[j] = (unsigned)vT[(size_t)(rowbase + (dir ? (LSC - 1) - (pv0_ + j) : pv0_ + j)) * 256 + ev]; __builtin_amdgcn_sched_barrier(0); } while (0)
          if (!prepqk) VLOAD();
          if (prepqk) {
            float gf[16], kk[16], qs[16], etot = 1.f;
#pragma unroll
            for (int j = 0; j < 16; ++j) { const float a = bf2f(zr[j]);
                if (ISA) { const float sg = sigmoidf_(a); gf[j] = lb + (1.f - lb) * sg; kk[j] = (1.f - lb) * (1.f - sg); const float q = bf2f(qr[j]); qs[j] = q * sigmoidf_(q) * qscale; }
                else { const float y = bf2f(yr[j]) + upb;
                    gf[j] = __builtin_amdgcn_exp2f((fminf(y, 0.f) * 1.4426950408889634f - __builtin_amdgcn_logf(1.f + __expf(-fabsf(y)))) * 0.0625f); kk[j] = a; qs[j] = bf2f(qr[j]) * qscale; }
                etot *= gf[j]; }
            float eb = 1.f, kt[16];
            VLOAD();
#pragma unroll
            for (int j = 0; j < 16; ++j) { eb *= gf[j];
                const float ebi = __builtin_amdgcn_rcpf(eb);
                if (OUT) { QD[j * DKP + d] = (bf16_t)f2bf(qs[j] * eb); KD[j * DKP + d] = (bf16_t)f2bf(kk[j] * ebi); }
                kt[j] = kk[j] * (etot * ebi); }
            u32x4 w0, w1; w0.x = pk2(kt[0], kt[1]); w0.y = pk2(kt[2], kt[3]); w0.z = pk2(kt[4], kt[5]); w0.w = pk2(kt[6], kt[7]);
            w1.x = pk2(kt[8], kt[9]); w1.y = pk2(kt[10], kt[11]); w1.z = pk2(kt[12], kt[13]); w1.w = pk2(kt[14], kt[15]);
            *(LAS u32x4*)(KTT + d * 16) = w0; *(LAS u32x4*)(KTT + d * 16 + 8) = w1;
            DEC[d] = etot; dsum *= etot;
          }
          u32x4 v0, v1; v0.x = vr[0] | (vr[1] << 16); v0.y = vr[2] | (vr[3] << 16); v0.z = vr[4] | (vr[5] << 16); v0.w = vr[6] | (vr[7] << 16);
          v1.x = vr[8] | (vr[9] << 16); v1.y = vr[10] | (vr[11] << 16); v1.z = vr[12] | (vr[13] << 16); v1.w = vr[14] | (vr[15] << 16);
          *(LAS u32x4*)(VT + ev * 16) = v0; *(LAS u32x4*)(VT + ev * 16 + 8) = v1; }
#ifdef PROBE_STAGES
        { const unsigned long long t1 = __builtin_amdgcn_s_memrealtime(); tt[0] += t1 - ts0; ts0 = t1; }
#endif
        LDS_BARRIER();
#ifdef PROBE_STAGES
        { const unsigned long long t1 = __builtin_amdgcn_s_memrealtime(); tt[1] += t1 - ts0; ts0 = t1; }
#endif
        f32x4 ofv[4], os[4];
        if (OUT && dir == 1) {
#pragma unroll
            for (int kq = 0; kq < 4; ++kq)
#pragma unroll
                for (int r = 0; r < 4; ++r) { const size_t row = (size_t)(rowbase + (LSC - 1) - (ssi * 64 + kq * 16 + lq * 4 + r));
                    ofv[kq][r] = ofw[row * 512 + h * 128 + e0 + l15]; }
        }
        if (ssi < LSC / 64 - 1) GLA_LOADRAW(ssi + 1);
#pragma unroll
        for (int kq = 0; kq < 4; ++kq) {
            const int pos0 = ssi * 64 + kq * 16;
            LAS unsigned char* cb = lds + kq * GC_STRIDE;
            const LAS bf16_t* QD = (const LAS bf16_t*)cb; const LAS bf16_t* KD = (const LAS bf16_t*)(cb + GC_KD); const LAS bf16_t* KTT = (const LAS bf16_t*)(cb + GC_KTT);
            const LAS bf16_t* VT = (const LAS bf16_t*)(cb + GC_VT); const LAS float* DEC = (const LAS float*)(cb + GC_DEC);
            bf16x8 aq[NKS];
            const bf16x4 vt = *(const LAS bf16x4*)(VT + (e0 + l15) * 16 + lq * 4);
            f32x4 o = {0.f, 0.f, 0.f, 0.f};
            if (OUT) {
                f32x4 att = {0.f, 0.f, 0.f, 0.f};
                __builtin_amdgcn_s_setprio(1);
#pragma unroll
                for (int ks = 0; ks < NKS; ++ks) { aq[ks] = *(const LAS bf16x8*)(QD + l15 * DKP + ks * 32 + lq * 8);
                    const bf16x8 bk = *(const LAS bf16x8*)(KD + l15 * DKP + ks * 32 + lq * 8); att = MFMA16(aq[ks], bk, att); }
#pragma unroll
                for (int r = 0; r < 4; ++r) { const int i = lq * 4 + r; const bool keep = l15 <= i; ATT[i * 16 + l15] = keep ? (bf16_t)f2bf(att[r]) : (bf16_t)0; }
                WAVE_LDS_FENCE();
                const bf16x4 aatt = *(const LAS bf16x4*)(ATT + l15 * 16 + lq * 4);
                o = MFMA16K16(aatt, vt, o);
#pragma unroll
                for (int ks = 0; ks < NKS; ++ks) { const bf16x8 bst = *(const LAS bf16x8*)(STB + l15 * DKP + ks * 32 + lq * 8); o = MFMA16(aq[ks], bst, o); }
            }
#pragma unroll
            for (int nt = 0; nt < NNT; ++nt) { const bf16x4 bkt = *(const LAS bf16x4*)(KTT + (nt * 16 + l15) * 16 + lq * 4);
                if (!OUT && nt == 0) __builtin_amdgcn_s_setprio(1);
                const float dec = DEC[nt * 16 + l15]; ST[nt] = MFMA16K16(vt, bkt, ST[nt] * dec); }
            __builtin_amdgcn_s_setprio(0);
            if (OUT) {
                WAVE_LDS_FENCE();
#pragma unroll
                for (int nt = 0; nt < NNT; ++nt)
#pragma unroll
                    for (int r = 0; r < 4; ++r) STB[(lq * 4 + r) * DKP + nt * 16 + l15] = (bf16_t)f2bf(ST[nt][r]);
                if (dir == 0) {
#pragma unroll
                    for (int r = 0; r < 4; ++r) ofw[(size_t)(rowbase + pos0 + lq * 4 + r) * 512 + h * 128 + e0 + l15] = o[r];
                } else {
                    os[kq] = o + ofv[kq];
#pragma unroll
                    for (int r = 0; r < 4; ++r) { float v = os[kq][r] * os[kq][r]; v = row16_sum(v);
                        if (l15 == 0) SSQ[(kq * 16 + lq * 4 + r) * 8 + wid] = v; }
                }
            }
        }
#ifdef PROBE_STAGES
        { const unsigned long long t1 = __builtin_amdgcn_s_memrealtime(); tt[2] += t1 - ts0; ts0 = t1; }
#endif
        LDS_BARRIER();
#ifdef PROBE_STAGES
        { const unsigned long long t1 = __builtin_amdgcn_s_memrealtime(); tt[3] += t1 - ts0; ts0 = t1; }
#endif
        if (OUT && dir == 1) {
            unsigned ogv[4][4];
#pragma unroll
            for (int kq = 0; kq < 4; ++kq)
#pragma unroll
                for (int r = 0; r < 4; ++r) ogv[kq][r] = ogT[(size_t)(rowbase + (LSC - 1) - (ssi * 64 + kq * 16 + lq * 4 + r)) * 256 + e0 + l15];
#pragma unroll
            for (int kq = 0; kq < 4; ++kq)
#pragma unroll
                for (int r = 0; r < 4; ++r) { const int i = lq * 4 + r; const size_t row = (size_t)(rowbase + (LSC - 1) - (ssi * 64 + kq * 16 + i));
                    const f32x4 a = *(const LAS f32x4*)(SSQ + (kq * 16 + i) * 8), b = *(const LAS f32x4*)(SSQ + (kq * 16 + i) * 8 + 4);
                    const float tot = (a[0] + a[1]) + (a[2] + a[3]) + (b[0] + b[1]) + (b[2] + b[3]); const float rs = rsqrtf(tot * (1.0f / 128.0f) + EPS);
                    const float og = bf2f(ogv[kq][r]); const float val = os[kq][r] * rs * nw * og * sigmoidf_(og);
                    oout[row * 512 + h * 128 + e0 + l15] = (bf16_t)f2bf(val); }
        }
    }
#undef GLA_LOADRAW
#undef VLOAD
    if (!OUT) {
#pragma unroll
        for (int nt = 0; nt < NNT; ++nt)
#pragma unroll
            for (int r = 0; r < 4; ++r) Sg[(size_t)(e0 + lq * 4 + r) * DK + nt * 16 + l15] = ST[nt][r];
        if (prepqk) DSUM[ck * 128 + d] = dsum;
        __syncthreads();
        if (tid < DK) Dg[tid] = (DSUM[tid] * DSUM[128 + tid]) * (DSUM[256 + tid] * DSUM[384 + tid]);
    }
    __syncthreads();
    }
}
template <bool OUT>
__device__ __forceinline__ void rglru_item(LAS unsigned char* lds, const Params& p, const int l, const int item) {
    int tid_ = threadIdx.x; asm volatile("" : "+v"(tid_));
    const int tid = tid_, lane = tid & 63, w = __builtin_amdgcn_readfirstlane(tid >> 6);
    const int s = item >> 7, scc = item & 127, tb = scc * LCC;
    const int l15 = lane & 15, lq = lane >> 4, c = 64 * w + lane;
    unsigned char* ws = p.ws;
    const bf16_t* proj = (const bf16_t*)(ws + WS_PROJ);
    LAS bf16_t* XC = (LAS bf16_t*)(lds + w * 15360); LAS float* AS = (LAS float*)(lds + w * 15360 + 9216); LAS bf16_t* US = (LAS bf16_t*)(lds + w * 15360 + 9216 + 4096);
    const bf16_t* xT = proj + (size_t)(16 + (w >> 2)) * PTILE + (w & 3) * 64 + lane;
    const bf16_t* yT = proj + (size_t)(18 + (w >> 2)) * PTILE + (w & 3) * 64 + lane;
    bf16_t* oc = (bf16_t*)(ws + WS_O) + (size_t)2 * MG * 512;
    float* CH = (float*)(ws + WS_CH); float* CP = (float*)(ws + WS_CP);
    const float cw0 = p.in[9][(l * 4 + 0) * 512 + c], cw1 = p.in[9][(l * 4 + 1) * 512 + c], cw2 = p.in[9][(l * 4 + 2) * 512 + c], cw3 = p.in[9][(l * 4 + 3) * 512 + c], cb = p.in[10][l * 512 + c];
    {
        float xin[67];
#pragma unroll
        for (int i = 0; i < 67; ++i) { const int t = tb - 2 + i; const int tc = t < 0 ? 0 : (t >= SEQ ? SEQ - 1 : t); const float xx = bf2f((unsigned)xT[(size_t)(s * SEQ + tc) * 256]); xin[i] = (t == tc) ? xx : 0.f; }
#pragma unroll
        for (int i = 0; i < 64; ++i) XC[i * 72 + lane] = (bf16_t)f2bf(cb + cw0 * xin[i] + cw1 * xin[i + 1] + cw2 * xin[i + 2] + cw3 * xin[i + 3]);
    }
#pragma unroll 1
    for (int dir = 0; dir < 2; ++dir) {
        bf16x8 wfa[4][2], wfx[4][2]; float ba[4], bx[4], sp[4];
        { const bf16_t* rgw = (const bf16_t*)(ws + WS_RGW);
#pragma unroll
            for (int nt = 0; nt < 4; ++nt) {
#pragma unroll
                for (int ks = 0; ks < 2; ++ks) { wfa[nt][ks] = *(const bf16x8*)(rgw + (size_t)((((dir * 8 + w) * 2 + 0) * 4 + nt) * 2 + ks) * 512 + lane * 8);
                    wfx[nt][ks] = *(const bf16x8*)(rgw + (size_t)((((dir * 8 + w) * 2 + 1) * 4 + nt) * 2 + ks) * 512 + lane * 8); }
                const int cj = (l * 2 + dir) * 512 + 64 * w + nt * 16 + l15;
                ba[nt] = p.in[12][cj]; bx[nt] = p.in[14][cj]; const float lam = p.in[15][cj];
                sp[nt] = fmaxf(-lam, 0.f) + __logf(1.f + __expf(-fabsf(lam)));
            } }
        const size_t cidx = ((size_t)(s * NCC + scc) * 2 + dir) * 512 + c;
        float hst = OUT ? CH[cidx] : 0.f, pprod = 1.f;
#pragma unroll 1
        for (int sbi = 0; sbi < 4; ++sbi) {
            const int sb = dir ? 3 - sbi : sbi, t0 = tb + 16 * sb;
            LAS bf16_t* XCS = XC + (t0 - tb) * 72;
            unsigned hv[16], yv[16];
            if (OUT && dir == 1) {
#pragma unroll
                for (int i = 0; i < 16; ++i) { const size_t row = (size_t)(s * SEQ + t0 + i); hv[i] = (unsigned)oc[row * 512 + c]; yv[i] = (unsigned)yT[row * 256]; }
                __builtin_amdgcn_sched_barrier(0);
            }
            WAVE_LDS_FENCE();
            f32x4 accr[4], acci[4];
            const bf16x8 af0 = *(const LAS bf16x8*)(XCS + l15 * 72 + lq * 8), af1 = *(const LAS bf16x8*)(XCS + l15 * 72 + 32 + lq * 8);
            __builtin_amdgcn_s_setprio(1);
#pragma unroll
            for (int nt = 0; nt < 4; ++nt) { f32x4 z = {0.f, 0.f, 0.f, 0.f};
                accr[nt] = MFMA16(af0, wfa[nt][0], z); accr[nt] = MFMA16(af1, wfa[nt][1], accr[nt]);
                acci[nt] = MFMA16(af0, wfx[nt][0], z); acci[nt] = MFMA16(af1, wfx[nt][1], acci[nt]); }
            __builtin_amdgcn_s_setprio(0);
#pragma unroll
            for (int nt = 0; nt < 4; ++nt)
#pragma unroll
                for (int r = 0; r < 4; ++r) { const int t = lq * 4 + r, jj = nt * 16 + l15;
                    const float rr = sigmoidf_(accr[nt][r] + ba[nt]), ii = sigmoidf_(acci[nt][r] + bx[nt]);
                    const float la = -8.0f * rr * sp[nt]; const float a = __expf(la); const float mult = __builtin_amdgcn_sqrtf(fmaxf(fmaf(-a, a, 1.0f), 0.f));
                    AS[t * 64 + jj] = a; US[t * 64 + jj] = (bf16_t)f2bf(mult * ii * bf2f((unsigned)XCS[t * 72 + jj])); }
            WAVE_LDS_FENCE();
            if (dir == 0) {
#pragma unroll
                for (int i = 0; i < 16; ++i) { const float a = AS[i * 64 + lane], u = bf2f((unsigned)US[i * 64 + lane]); hst = a * hst + u; pprod *= a;
                    if (OUT) oc[(size_t)(s * SEQ + t0 + i) * 512 + c] = (bf16_t)f2bf(hst); }
            } else {
#pragma unroll
                for (int i2 = 0; i2 < 16; ++i2) { const int i = 15 - i2; const float a = AS[i * 64 + lane], u = bf2f((unsigned)US[i * 64 + lane]); hst = a * hst + u; pprod *= a;
                    if (OUT) oc[(size_t)(s * SEQ + t0 + i) * 512 + c] = (bf16_t)f2bf((bf2f(hv[i]) + hst) * gelu_tanh(bf2f(yv[i]))); }
            }
            WAVE_LDS_FENCE();
        }
        if (!OUT) { CH[cidx] = hst; CP[cidx] = pprod; }
    }
}

__device__ __forceinline__ void scan_phase(const Params& p) {
    unsigned char* ws = p.ws;
    int tid_ = threadIdx.x; asm volatile("" : "+v"(tid_));
    const int gtid = blockIdx.x * NTHR + tid_, nthr = gridDim.x * NTHR;
    constexpr int NA = GS * 4 * 2 * 128 * 128, NB = GS * 4 * 2 * 128 * 64;
    for (int idx = gtid; idx < NA + NB; idx += nthr) {
        const bool isa = idx < NA; const int i = isa ? idx : idx - NA; const int per = isa ? 16384 : 8192, dk = isa ? 128 : 64;
        const int shd = i / per, ed = i - shd * per, d = ed & (dk - 1), dir = shd & 1;
        float* S = (float*)(ws + (isa ? WS_SA : WS_SB)) + (size_t)shd * NSC * per + ed;
        const float* D = (const float*)(ws + (isa ? WS_DA : WS_DB)) + (size_t)shd * NSC * dk + d;
        float cur = 0.f;
        { float tmp[NSC], dd[NSC];
#pragma unroll
            for (int k = 0; k < NSC; ++k) { const int sc = dir ? NSC - 1 - k : k; tmp[k] = S[(size_t)sc * per]; dd[k] = D[(size_t)sc * dk]; }
#pragma unroll
            for (int k = 0; k < NSC; ++k) { const int sc = dir ? NSC - 1 - k : k; S[(size_t)sc * per] = cur; cur = cur * dd[k] + tmp[k]; }
        }
    }
    if (gtid < GS * 2 * 512) {
        const int s = gtid >> 10, dir = (gtid >> 9) & 1, c = gtid & 511;
        float* CH = (float*)(ws + WS_CH); const float* CP = (const float*)(ws + WS_CP);
        float cur = 0.f;
#pragma unroll 1
        for (int q = 0; q < NCC; q += 32) {
            float tmp[32], dd[32];
#pragma unroll
            for (int k = 0; k < 32; ++k) { const int scc = dir ? NCC - 1 - (q + k) : q + k; const size_t ix = ((size_t)(s * NCC + scc) * 2 + dir) * 512 + c; tmp[k] = CH[ix]; dd[k] = CP[ix]; }
#pragma unroll
            for (int k = 0; k < 32; ++k) { const int scc = dir ? NCC - 1 - (q + k) : q + k; const size_t ix = ((size_t)(s * NCC + scc) * 2 + dir) * 512 + c; CH[ix] = cur; cur = cur * dd[k] + tmp[k]; }
        }
    }
}

__device__ __forceinline__ float bfe(const u32x4& v, int e) { const unsigned wd = (e >> 1) == 0 ? v.x : (e >> 1) == 1 ? v.y : (e >> 1) == 2 ? v.z : v.w; return (e & 1) ? bf2f(wd >> 16) : bf2f(wd & 0xffffu); }
__device__ __forceinline__ void convgelu_phase(const Params& p, const int l) {
    unsigned char* ws = p.ws;
    const bf16_t* __restrict__ u = (const bf16_t*)(ws + WS_PROJ); bf16_t* __restrict__ g = (bf16_t*)(ws + WS_O);
    int tid_ = threadIdx.x; asm volatile("" : "+v"(tid_));
    const int gtid = blockIdx.x * NTHR + tid_, nthr = gridDim.x * NTHR;
    const float* cw = p.in[20] + (size_t)l * 3 * 2 * DFF; const float* cbias = p.in[21] + (size_t)l * 2 * DFF;
    constexpr int NCG = DFF / 8, RUN = 16;
    for (int it = gtid; it < NCG * (MG / RUN); it += nthr) {
        const int cg8 = it % NCG, run = it / NCG, c = cg8 * 8, row0 = run * RUN, t0 = row0 & (SEQ - 1);
        float wg[3][8], wv[3][8], bg[8], bv[8];
#pragma unroll
        for (int j = 0; j < 3; ++j)
#pragma unroll
            for (int e = 0; e < 8; ++e) { wg[j][e] = cw[(size_t)j * 2 * DFF + c + e]; wv[j][e] = cw[(size_t)j * 2 * DFF + DFF + c + e]; }
#pragma unroll
        for (int e = 0; e < 8; ++e) { bg[e] = cbias[c + e]; bv[e] = cbias[DFF + c + e]; }
        const u32x4 z4 = {0, 0, 0, 0};
        u32x4 pg = z4, pv = z4, cg_, cv_;
        { const size_t rp = (size_t)(t0 > 0 ? row0 - 1 : row0) * (2 * DFF); pg = __builtin_nontemporal_load((const u32x4*)(u + rp + c)); pv = __builtin_nontemporal_load((const u32x4*)(u + rp + DFF + c)); if (t0 == 0) { pg = z4; pv = z4; } }
        cg_ = __builtin_nontemporal_load((const u32x4*)(u + (size_t)row0 * (2 * DFF) + c)); cv_ = __builtin_nontemporal_load((const u32x4*)(u + (size_t)row0 * (2 * DFF) + DFF + c));
#pragma unroll 4
        for (int i = 0; i < RUN; ++i) {
            u32x4 ng = z4, nv = z4;
            { const bool has = t0 + i + 1 < SEQ; const size_t rn = (size_t)(has ? row0 + i + 1 : row0 + i) * (2 * DFF); ng = __builtin_nontemporal_load((const u32x4*)(u + rn + c)); nv = __builtin_nontemporal_load((const u32x4*)(u + rn + DFF + c)); if (!has) { ng = z4; nv = z4; } }
            float o[8];
#pragma unroll
            for (int e = 0; e < 8; ++e) { const float a = bg[e] + wg[0][e] * bfe(pg, e) + wg[1][e] * bfe(cg_, e) + wg[2][e] * bfe(ng, e);
                const float b = bv[e] + wv[0][e] * bfe(pv, e) + wv[1][e] * bfe(cv_, e) + wv[2][e] * bfe(nv, e); o[e] = gelu_tanh(a) * b; }
            u32x4 w4; w4.x = pk2(o[0], o[1]); w4.y = pk2(o[2], o[3]); w4.z = pk2(o[4], o[5]); w4.w = pk2(o[6], o[7]);
            *(u32x4*)(g + (size_t)(row0 + i) * DFF + c) = w4;
            pg = cg_; pv = cv_; cg_ = ng; cv_ = nv;
        }
    }
}

#ifndef REP_M1
#define REP_M1 1
#endif
#ifndef REP_M3
#define REP_M3 1
#endif
#ifndef REP_MISC
#define REP_MISC 1
#endif
#ifndef REP_RG
#define REP_RG 1
#endif
#ifndef REP_G1
#define REP_G1 1
#endif
#ifndef REP_G5
#define REP_G5 1
#endif
#define PB_G1 1
#define PB_M1 2
#define PB_M2 3
#define PB_M3 4
#define PB_G3 5
#define PB_G4 6
#define PB_N 7
#define PB_G5 8
#define PB_CONV 9
#define PB_G6 10
#ifndef PROBE_A
#define PROBE_A(c) ((c) == PB_M1 || (c) == PB_M3)
#endif
#ifndef PROBE_B
#define PROBE_B(c) ((c) == PB_G1 || (c) == PB_G3 || (c) == PB_G4 || (c) == PB_G5 || (c) == PB_G6)
#endif
__global__ void __launch_bounds__(NTHR, 2) mega_fwd(Params p) {
    extern __shared__ __attribute__((aligned(16))) unsigned char lds_raw[];
    LAS unsigned char* lds = (LAS unsigned char*)lds_raw;
    cg::grid_group grid = cg::this_grid();
    volatile LAS unsigned* bst = (volatile LAS unsigned*)(lds + 131072);
    if (threadIdx.x < 2) bst[threadIdx.x] = 0u;
    __syncthreads();
    const XcdBarrier bar = xcd_barrier_post((unsigned*)(p.ws + WS_BAR), bst);
    unsigned char* ws = p.ws;
    const int G = gridDim.x, bid = blockIdx.x;
    bf16_t* hbuf = (bf16_t*)(ws + WS_H);
    bf16_t* proj = (bf16_t*)(ws + WS_PROJ);

#pragma unroll 1
    for (int l = 0; l < DEPTH; ++l) {
        convert_phase(lds, p, l);
        if (l == 0) grid.sync(); else xcd_barrier(bar);
#pragma unroll 1
        for (int grp = 0; grp < NGRP; ++grp) {
            float* xg = p.out + (size_t)grp * MG * DM;
#pragma unroll 1
            for (int ph_ = 0; ph_ < 11; ++ph_) {
                int ph = ph_; asm volatile("" : "+s"(ph));
                if (ph == 0) {
                    if (grp > 0) continue;
                    if (l == 0) norm_phase(p.in[0], xg, p.in[2] + l * DM, hbuf, MG);
                    else norm_phase(xg, nullptr, p.in[2] + l * DM, hbuf, MG);
                } else if (ph == 1 || ph == 8) {
                    const bool up = ph == 8; const int N = up ? 2 * DFF : NINP;
                    Gemm g{hbuf, (const bf16_t*)(ws + (up ? WS_WUP : WS_WIN)), MG, N, DM}; pg8::StaticOrder S; S.init(MG, N, G, bid);
                    EpiStoreBf16 E{proj, up ? 2 * DFF : 256, up ? 0 : 1}; pg8::gemm_phase<EpiStoreBf16, pg8::StaticOrder>(lds, g, S, E);
                } else if (ph == 2) {
                    for (int it = bid; it < 256; it += G) { if (it < 128) gla_item<true, false>(lds, p, l, it, nullptr); else gla_item<false, false>(lds, p, l, it - 128, nullptr); rglru_item<false>(lds, p, l, it); __syncthreads(); }
                } else if (ph == 3) {
                    scan_phase(p);
                } else if (ph == 4) {
                    for (int it = bid; it < 256; it += G) { if (it < 128) gla_item<true, true>(lds, p, l, it, nullptr); else gla_item<false, true>(lds, p, l, it - 128, nullptr); rglru_item<true>(lds, p, l, it); __syncthreads(); }
                } else if (ph == 5) {
                    Gemm g{(const bf16_t*)(ws + WS_O), (const bf16_t*)(ws + WS_WB), 3 * MG, 3 * DM, 512}; BranchOrder S{MG / 256, G, bid};
                    EpiGate E{proj, hbuf, MG / 256}; pg8::gemm_phase<EpiGate, BranchOrder>(lds, g, S, E);
                } else if (ph == 6 || ph == 10) {
                    const bool dn = ph == 10;
                    Gemm g{dn ? (const bf16_t*)(ws + WS_O) : (const bf16_t*)hbuf, (const bf16_t*)(ws + (dn ? WS_WDN : WS_WOUT)), MG, DM, dn ? DFF : DM}; pg8::StaticOrder S; S.init(MG, DM, G, bid);
                    EpiResid E{xg}; pg8::gemm_phase<EpiResid, pg8::StaticOrder>(lds, g, S, E);
                    if (dn && grp + 1 < NGRP) {
                        float* xn = p.out + (size_t)(grp + 1) * MG * DM;
                        if (l == 0) norm_phase(p.in[1] + (size_t)grp * MG * DM, xn, p.in[2] + l * DM, hbuf, MG);
                        else norm_phase(xn, nullptr, p.in[2] + l * DM, hbuf, MG); }
                } else if (ph == 7) {
                    norm_phase(xg, nullptr, p.in[18] + l * DM, hbuf, MG);
                } else {
                    convgelu_phase(p, l);
                }
                xcd_barrier(bar);
            }
        }
    }
    final_norm_phase(p.out, p.in[23], NSEQ * SEQ);
}

extern "C" void kernel_launch(void* const* d_in, const int* in_sizes, int n_in, void* d_out, int out_size, void* d_ws, size_t ws_size, hipStream_t stream) {
    static int grid = 0;
    if (grid == 0) {
        if (n_in != 24 || ws_size < WS_END) { fprintf(stderr, "kernel_launch: need 24 inputs and %zu bytes of workspace (got %d, %zu)\n", (size_t)WS_END, n_in, ws_size); grid = -1; return; }
        int dev = 0, cus = 0, per_cu = 0;
        hipGetDevice(&dev); hipDeviceGetAttribute(&cus, hipDeviceAttributeMultiprocessorCount, dev);
        hipFuncSetAttribute((const void*)mega_fwd, hipFuncAttributeMaxDynamicSharedMemorySize, LDS_BYTES);
        hipOccupancyMaxActiveBlocksPerMultiprocessor(&per_cu, (const void*)mega_fwd, NTHR, LDS_BYTES);
        if (per_cu < 1) { fprintf(stderr, "kernel_launch: occupancy query says 0 blocks per CU\n"); per_cu = 1; }
        grid = cus;
        (void)hipGetLastError();
    }
    if (grid < 0) return;
    if (hipMemsetAsync((char*)d_ws + WS_BAR, 0, XCD_BAR_WORDS * 4, stream) != hipSuccess) { fprintf(stderr, "kernel_launch: memset of the barrier words failed\n"); return; }
    Params p{};
    for (int i = 0; i < 24; ++i) p.in[i] = (const float*)d_in[i];
    p.out = (float*)d_out; p.ws = (unsigned char*)d_ws;
    void* args[] = {&p};
    hipError_t e = hipLaunchCooperativeKernel((const void*)mega_fwd, dim3(grid), dim3(NTHR), args, LDS_BYTES, stream);
    if (e != hipSuccess) fprintf(stderr, "cooperative launch failed: %s (grid %d)\n", hipGetErrorString(e), grid);
}
```

```cpp
#include <hip/hip_runtime.h>
#include <hip/hip_cooperative_groups.h>
#include <cstdio>
namespace cg = cooperative_groups;

#define LAS __attribute__((address_space(3)))
typedef unsigned short bf16_t;
typedef short bf16x8 __attribute__((ext_vector_type(8)));
typedef float f32x4 __attribute__((ext_vector_type(4)));
typedef float f32x2 __attribute__((ext_vector_type(2)));
typedef unsigned u32x4 __attribute__((ext_vector_type(4)));
typedef unsigned u32x2 __attribute__((ext_vector_type(2)));

constexpr int DM = 1024, SEQ = 8192, NSEQ = 6, DEPTH = 4;
constexpr int GS = 2;
constexpr int MG = GS * SEQ;
constexpr int NGRP = NSEQ / GS;
constexpr int NIN = 8224, NINP = 8704;
constexpr int DFF = 2816;
constexpr int LSC = 512, NSC = SEQ / LSC;
constexpr int NSCA = 32;
constexpr int LCC = 64, NCC = SEQ / LCC;
constexpr int NTHR = 512;
constexpr int LDS_BYTES = 131072 + 256;
constexpr float EPS = 1e-6f;

constexpr size_t WS_WIN  = 0;
constexpr size_t WS_WB   = WS_WIN  + (size_t)NINP * DM * 2;
constexpr size_t WS_WOUT = WS_WB   + (size_t)3 * DM * 512 * 2;
constexpr size_t WS_WUP  = WS_WOUT + (size_t)DM * DM * 2;
constexpr size_t WS_WDN  = WS_WUP  + (size_t)2 * DFF * DM * 2;
constexpr size_t WS_H    = WS_WDN  + (size_t)DM * DFF * 2;
constexpr size_t WS_PROJ = WS_H    + (size_t)MG * DM * 2;
constexpr size_t PTILE   = (size_t)MG * 256;
constexpr size_t WS_O    = WS_PROJ + 34 * PTILE * 2;
constexpr size_t WS_SA   = WS_O    + (size_t)3 * MG * 512 * 2;
constexpr size_t WS_SB   = WS_SA   + (size_t)GS * 4 * 2 * NSCA * 128 * 128 * 4;
constexpr size_t WS_DA   = WS_SB   + (size_t)GS * 4 * 2 * NSCA * 128 * 64 * 4;
constexpr size_t WS_DB   = WS_DA   + (size_t)GS * 4 * 2 * NSCA * 128 * 4;
constexpr size_t WS_CH   = WS_DB   + (size_t)GS * 4 * 2 * NSCA * 64 * 4;
constexpr size_t WS_CP   = WS_CH   + (size_t)GS * NCC * 2 * 512 * 4;
constexpr size_t WS_BAR  = WS_CP   + (size_t)GS * NCC * 2 * 512 * 4;
constexpr size_t WS_RGW  = WS_BAR  + 16384;
constexpr size_t WS_OFB  = WS_RGW  + 262144;
constexpr size_t WS_END  = WS_OFB  + (size_t)MG * 512 * 4;
static_assert((size_t)MG * 2 * DFF * 2 <= 34 * PTILE * 2, "u buffer fits the projection region");
static_assert((size_t)MG * DFF * 2 <= WS_DA - WS_O, "g buffer fits o + state region");

struct Params { const float* in[24]; float* out; unsigned char* ws; };

__device__ __forceinline__ float bf2f(unsigned b) { return __uint_as_float(b << 16); }
typedef __bf16 bf16v2_t __attribute__((ext_vector_type(2)));
__device__ __forceinline__ unsigned pk2(float lo, float hi) { const f32x2 f = {lo, hi}; const bf16v2_t v = __builtin_convertvector(f, bf16v2_t); return __builtin_bit_cast(unsigned, v); }
__device__ __forceinline__ unsigned f2bf(float f) { return pk2(f, f) & 0xffffu; }
__device__ __forceinline__ float sigmoidf_(float x) { return __builtin_amdgcn_rcpf(1.0f + __expf(-x)); }
__device__ __forceinline__ float gelu_tanh(float x) { const float t = 1.5957691216057308f * (x + 0.044715f * x * x * x); return x * __builtin_amdgcn_rcpf(1.0f + __expf(-t)); }
__device__ __forceinline__ float wave_sum(float v) {
#pragma unroll
    for (int o = 32; o >= 1; o >>= 1) v += __shfl_xor(v, o);
    return v;
}

namespace pg8 {
#define PG8_LAS __attribute__((address_space(3)))
typedef unsigned short bf16_t;
typedef short bf16x8 __attribute__((ext_vector_type(8)));
typedef float f32x4 __attribute__((ext_vector_type(4)));
typedef unsigned u32x4 __attribute__((ext_vector_type(4)));
constexpr int BM = 256, BK = 64, HALF = 128, HTB = HALF * BK * 2  , STAGE_BYTES = 8 * HTB, NXCD = 8, WGM = 8;

__host__ __device__ __forceinline__ int lds_byte(int r, int c) { const int st = (r >> 4) * 2 + (c >> 5), rr = r & 15, cc = c & 31, ob = rr * 64 + cc * 2; return st * 1024 + (ob ^ (((ob >> 9) & 1) << 5)); }
__host__ __device__ __forceinline__ void stage_rc(int b, int& R, int& C) { const int st = b / 1024, sb = b % 1024, swz = sb ^ (((sb >> 9) & 1) << 5); R = (st >> 1) * 16 + swz / 64; C = (st & 1) * 32 + (swz % 64) / 2; }
__host__ __device__ __forceinline__ int perm32(int rho) { const int n = rho >> 4, i = rho & 15; return 8 * (i >> 2) + 4 * n + (i & 3); }

struct Unit { int pm, pn; };
struct Gemm { const bf16_t* A; const bf16_t* Bt; int M, N, K; };

struct StaticOrder {
    int nM, nN, nwg, G, c;
    __host__ __device__ void init(int M, int N, int G_, int c_) { nM = M / BM; nN = N / BM; nwg = nM * nN; G = G_; c = c_; }
    __host__ __device__ bool next(int i, Unit& u) const {
        const long L = (long)i * G + c; if (L >= nwg) return false;
        int wgid = (int)L; { const int q = nwg / NXCD, r = nwg % NXCD, xcd = wgid % NXCD, off = wgid / NXCD; wgid = (xcd < r ? xcd * (q + 1) : r * (q + 1) + (xcd - r) * q) + off; }
        const int nig = WGM * nN, gid = wgid / nig, fm = gid * WGM, gsz = (nM - fm) < WGM ? (nM - fm) : WGM;
        u.pm = fm + ((wgid % nig) % gsz); u.pn = (wgid % nig) / gsz; return true;
    }
    __device__ __forceinline__ void a_ready(const Unit&) const {}
    __device__ __forceinline__ void done(const Unit&) const {}
};
__device__ __forceinline__ unsigned cvt_pk_bf16(float lo, float hi) { return ::pk2(lo, hi); }
typedef float f32x2 __attribute__((ext_vector_type(2)));
template <class Epi, class Sched>
__device__ __forceinline__ void gemm_phase(PG8_LAS unsigned char* lds, const Gemm g, const Sched& S, const Epi& E) {
    int tid_ = threadIdx.x; asm volatile("" : "+v"(tid_));
    const int tid = tid_, wid = __builtin_amdgcn_readfirstlane(tid >> 6), lane = tid & 63, wr = wid >> 2, wc = wid & 3, fr = lane & 15, fq = lane >> 4;
    int K_ = g.K; asm volatile("" : "+s"(K_));
    const int K = K_, nt = K / BK;
    unsigned voffA[2], voffB[2];
#pragma unroll
    for (int i = 0; i < 2; ++i) { int R, C; stage_rc(tid * 16 + i * 8192, R, C); const int Rb = Epi::PERM ? ((R & ~31) + perm32(R & 31)) : R;
        voffA[i] = (unsigned)(R * K + C) * 2u; voffB[i] = (unsigned)(Rb * K + C) * 2u; }
    const size_t kstep = (size_t)(BK * 2);
    const size_t hstep = (size_t)HALF * K * 2;
    const size_t tstep = 2 * hstep;
    const unsigned ldsw = (unsigned)wid * 1024u;
    const int aoff = lds_byte(wr * 64 + fr, fq * 8), boff = lds_byte(wc * 32 + fr, fq * 8);
#define PG8_SA(b, h) (((b) * 2 + (h)) * HTB)
#define PG8_SB(b, h) ((4 + (b) * 2 + (h)) * HTB)
#define PG8_STAGE(bufoff, gbase, voff) do { _Pragma("unroll") for (int _i = 0; _i < 2; ++_i) \
        __builtin_amdgcn_global_load_lds((const unsigned*)((const char*)(gbase) + (voff)[_i]), (PG8_LAS unsigned*)(lds + (bufoff) + ldsw + _i * 8192), 16, 0, 0); } while (0)
#define PG8_LDA(dst, b, h) do { _Pragma("unroll") for (int m = 0; m < 4; ++m) _Pragma("unroll") for (int k = 0; k < 2; ++k) dst[m][k] = *(const PG8_LAS bf16x8*)(lds + PG8_SA(b, h) + aoff + m * 2048 + k * 1024); } while (0)
#define PG8_LDB(dst, b, h) do { _Pragma("unroll") for (int n = 0; n < 2; ++n) _Pragma("unroll") for (int k = 0; k < 2; ++k) dst[n][k] = *(const PG8_LAS bf16x8*)(lds + PG8_SB(b, h) + boff + n * 2048 + k * 1024); } while (0)
#define PG8_MMA(ai, bj, At, Bt) do { __builtin_amdgcn_s_setprio(1); _Pragma("unroll") for (int m = 0; m < 4; ++m) _Pragma("unroll") for (int n = 0; n < 2; ++n) _Pragma("unroll") for (int k = 0; k < 2; ++k) \
        acc[ai][bj][m][n] = __builtin_amdgcn_mfma_f32_16x16x32_bf16(Bt[n][k], At[m][k], acc[ai][bj][m][n], 0, 0, 0); __builtin_amdgcn_s_setprio(0); } while (0)
#define PG8_WAIT_V(n) asm volatile("s_waitcnt vmcnt(" #n ")" ::: "memory")
#define PG8_WAIT_L(n) asm volatile("s_waitcnt lgkmcnt(" #n ")" ::: "memory")
#define PG8_BAR __builtin_amdgcn_s_barrier()
#define PG8_SCHED __builtin_amdgcn_sched_barrier(0)
    Unit cur, nxt; int ui = 0;
    if (!S.next(0, cur)) return;
    f32x4 acc[2][2][4][2];
#pragma unroll
    for (int a = 0; a < 2; ++a)
#pragma unroll
        for (int b = 0; b < 2; ++b)
#pragma unroll
            for (int m = 0; m < 4; ++m)
#pragma unroll
                for (int n = 0; n < 2; ++n) acc[a][b][m][n] = (f32x4){0.f, 0.f, 0.f, 0.f};
    bf16x8 At[4][2], B0[2][2], B1[2][2];
    const char* cA = (const char*)g.A + (size_t)cur.pm * tstep; const char* cB = (const char*)g.Bt + (size_t)cur.pn * tstep;
    S.a_ready(cur);
    PG8_STAGE(PG8_SB(0, 0), cB, voffB); PG8_STAGE(PG8_SA(0, 0), cA, voffA); PG8_STAGE(PG8_SB(0, 1), cB + hstep, voffB); PG8_STAGE(PG8_SA(0, 1), cA + hstep, voffA);
    if (wr == 1) PG8_BAR;
    PG8_WAIT_V(4); PG8_BAR;
    PG8_STAGE(PG8_SB(1, 0), cB + kstep, voffB); PG8_STAGE(PG8_SA(1, 0), cA + kstep, voffA); PG8_STAGE(PG8_SB(1, 1), cB + hstep + kstep, voffB);
    PG8_WAIT_V(6); PG8_BAR;
    for (;;) {
        const bool has_next = S.next(ui + 1, nxt);
        const char* nA = has_next ? (const char*)g.A + (size_t)nxt.pm * tstep : cA; const char* nB = has_next ? (const char*)g.Bt + (size_t)nxt.pn * tstep : cB;
#pragma unroll 1
        for (int t = 0; t < nt; t += 2) {
            const bool last = (t == nt - 2);
            const char* a1 = cA + (size_t)(t + 1) * kstep;
            const char* a2 = last ? nA : cA + (size_t)(t + 2) * kstep; const char* b2 = last ? nB : cB + (size_t)(t + 2) * kstep;
            const char* a3 = a2 + kstep; const char* b3 = b2 + kstep;
            if (last && has_next) S.a_ready(nxt);
            PG8_LDB(B0, 0, 0); PG8_SCHED; PG8_LDA(At, 0, 0); PG8_STAGE(PG8_SA(1, 1), a1 + hstep, voffA);
            PG8_WAIT_L(8); PG8_BAR; PG8_WAIT_L(0); PG8_MMA(0, 0, At, B0); PG8_BAR; PG8_SCHED;
            PG8_LDB(B1, 0, 1); PG8_STAGE(PG8_SB(0, 0), b2, voffB);
            PG8_BAR; PG8_WAIT_L(0); PG8_MMA(0, 1, At, B1); PG8_BAR;
            PG8_LDA(At, 0, 1); PG8_STAGE(PG8_SA(0, 0), a2, voffA);
            PG8_BAR; PG8_WAIT_L(0); PG8_MMA(1, 0, At, B0); PG8_BAR; PG8_SCHED;
            PG8_STAGE(PG8_SB(0, 1), b2 + hstep, voffB);
            PG8_WAIT_V(6); PG8_BAR; PG8_MMA(1, 1, At, B1); PG8_BAR;
            PG8_LDB(B0, 1, 0); PG8_SCHED; PG8_LDA(At, 1, 0); PG8_STAGE(PG8_SA(0, 1), a2 + hstep, voffA);
            PG8_WAIT_L(8); PG8_BAR; PG8_WAIT_L(0); PG8_MMA(0, 0, At, B0); PG8_BAR; PG8_SCHED;
            PG8_LDB(B1, 1, 1); PG8_STAGE(PG8_SB(1, 0), b3, voffB);
            PG8_BAR; PG8_WAIT_L(0); PG8_MMA(0, 1, At, B1); PG8_BAR;
            PG8_LDA(At, 1, 1); PG8_STAGE(PG8_SA(1, 0), a3, voffA);
            PG8_BAR; PG8_WAIT_L(0); PG8_MMA(1, 0, At, B0); PG8_BAR; PG8_SCHED;
            PG8_STAGE(PG8_SB(1, 1), b3 + hstep, voffB);
            PG8_WAIT_V(6); PG8_BAR; PG8_MMA(1, 1, At, B1); PG8_BAR;
        }
        if constexpr (!Epi::AFTER_DRAIN) { E(acc, cur, wr, wc, fr, fq); S.done(cur); }
        if (!has_next) break;
        if constexpr (!Epi::KEEP_ACC)
#pragma unroll
        for (int a = 0; a < 2; ++a)
#pragma unroll
            for (int b = 0; b < 2; ++b)
#pragma unroll
                for (int m = 0; m < 4; ++m)
#pragma unroll
                    for (int n = 0; n < 2; ++n) acc[a][b][m][n] = (f32x4){0.f, 0.f, 0.f, 0.f};
        cur = nxt; cA = nA; cB = nB; ++ui;
    }
    PG8_WAIT_V(0);
    if (wr == 0) PG8_BAR;
    PG8_BAR;
    if constexpr (Epi::AFTER_DRAIN) { E.fused(acc, cur, wr, wc, fr, fq, lds, wid, lane); S.done(cur); }
#undef PG8_SA
#undef PG8_SB
#undef PG8_STAGE
#undef PG8_LDA
#undef PG8_LDB
#undef PG8_MMA
#undef PG8_WAIT_V
#undef PG8_WAIT_L
#undef PG8_BAR
#undef PG8_SCHED
}
}
#define XB_TMO      128
#define XB_XCNT(j)  (256  + 64 * (j))
#define XB_XSUB(j)  (1280 + 64 * (j))
#define XB_XGEN(j)  (2304 + 64 * (j))
#define XB_TOP      3328
#define XB_TOPGEN   3392
#define XCD_BAR_WORDS 3456
#define XB_SPIN_CAP (1u << 18)

__device__ __forceinline__ unsigned xb_ld(unsigned* p)              { return __hip_atomic_load(p, __ATOMIC_RELAXED, __HIP_MEMORY_SCOPE_AGENT); }
__device__ __forceinline__ unsigned xb_add(unsigned* p, unsigned v) { return __hip_atomic_fetch_add(p, v, __ATOMIC_RELAXED, __HIP_MEMORY_SCOPE_AGENT); }
__device__ __forceinline__ unsigned xb_xcc_id() { return (unsigned)__builtin_amdgcn_s_getreg((3 << 11) | 20) & 0xFu; }
#define XB_SPIN(cond, bar) do { unsigned _sp = 0; while (cond) { __builtin_amdgcn_s_sleep(1); \
    if ((++_sp & 255u) == 0u) { if (xb_ld(&(bar)[XB_TMO])) break; if (_sp > XB_SPIN_CAP) { atomicAdd(&(bar)[XB_TMO], 1u); break; } } } } while (0)

struct XcdBarrier {
    unsigned* bar; unsigned x;
    volatile LAS unsigned* st;
};

__device__ __forceinline__ XcdBarrier xcd_barrier_post(unsigned* bar, volatile LAS unsigned* st) {
    XcdBarrier b; b.bar = bar; b.x = xb_xcc_id(); b.st = st;
    if (threadIdx.x == 0) (void)xb_add(&bar[XB_XCNT(b.x)], 1u);
    return b;
}
__device__ __forceinline__ void xcd_barrier_complete(unsigned* bar, unsigned x, unsigned& nloc, unsigned& nx) {
    const unsigned G = gridDim.x * gridDim.y * gridDim.z;
    unsigned sum, cnt, mine, sp = 0u;
    for (;;) {
        sum = 0u; cnt = 0u; mine = 0u;
#pragma unroll
        for (unsigned j = 0; j < 16; ++j) { const unsigned c = xb_ld(&bar[XB_XCNT(j)]); sum += c; cnt += (c > 0u) ? 1u : 0u; mine = (j == x) ? c : mine; }
        if (sum == G) break;
        __builtin_amdgcn_s_sleep(1);
        if ((++sp & 255u) == 0u) { if (xb_ld(&bar[XB_TMO])) break; if (sp > XB_SPIN_CAP) { atomicAdd(&bar[XB_TMO], 1u); break; } }
    }
    nloc = mine > 0u ? mine : 1u; nx = cnt > 0u ? cnt : 1u;
}

__device__ __forceinline__ void xcd_barrier(const XcdBarrier& b) {
    asm volatile("s_waitcnt vmcnt(0)" ::: "memory");
    __syncthreads();
    if (threadIdx.x == 0) {
        unsigned* bar = b.bar;
        __builtin_amdgcn_s_waitcnt(0);
        unsigned nloc = b.st[0], nx = b.st[1];
        if (nloc == 0u) { xcd_barrier_complete(bar, b.x, nloc, nx); b.st[0] = nloc; b.st[1] = nx; }
        const unsigned old = xb_add(&bar[XB_XSUB(b.x)], 1u);
        const unsigned gen = old / nloc;
        if (old + 1u == (gen + 1u) * nloc) {
            __builtin_amdgcn_fence(__ATOMIC_RELEASE, "agent");
            asm volatile("s_waitcnt vmcnt(0)" ::: "memory");
            const unsigned og = xb_add(&bar[XB_TOP], 1u);
            const unsigned tg = og / nx;
            if (og + 1u == (tg + 1u) * nx) xb_add(&bar[XB_TOPGEN], 1u);
            else XB_SPIN(xb_ld(&bar[XB_TOPGEN]) == tg, bar);
            __builtin_amdgcn_fence(__ATOMIC_ACQUIRE, "agent");
            xb_add(&bar[XB_XGEN(b.x)], 1u);
            asm volatile("s_waitcnt vmcnt(0)" ::: "memory");
        } else {
            XB_SPIN(xb_ld(&bar[XB_XGEN(b.x)]) == gen, bar);
            __builtin_amdgcn_fence(__ATOMIC_ACQUIRE, "agent");
            asm volatile("s_waitcnt vmcnt(0)" ::: "memory");
        }
    }
    __syncthreads();
}

using pg8::Unit; using pg8::Gemm;

struct EpiStoreBf16 {
    static constexpr bool PERM = true, AFTER_DRAIN = false, KEEP_ACC = false;
    bf16_t* O; int ldc; int tile_major;
    __device__ __forceinline__ void operator()(const f32x4 (&acc)[2][2][4][2], const Unit& u, int wr, int wc, int fr, int fq) const {
        const int row0 = u.pm * 256 + wr * 64 + fr; bf16_t* base = O; int colt = u.pn * 256;
        if (tile_major) { base += (size_t)u.pn * PTILE; colt = 0; }
        const int col0 = colt + wc * 32 + 8 * fq;
#pragma unroll
        for (int ai = 0; ai < 2; ++ai)
#pragma unroll
            for (int m = 0; m < 4; ++m) { bf16_t* rowp = base + (size_t)(row0 + ai * 128 + m * 16) * ldc + col0;
#pragma unroll
                for (int bj = 0; bj < 2; ++bj) { const f32x4 v0 = acc[ai][bj][m][0], v1 = acc[ai][bj][m][1];
                    u32x4 w; w.x = pg8::cvt_pk_bf16(v0[0], v0[1]); w.y = pg8::cvt_pk_bf16(v0[2], v0[3]); w.z = pg8::cvt_pk_bf16(v1[0], v1[1]); w.w = pg8::cvt_pk_bf16(v1[2], v1[3]);
                    __builtin_nontemporal_store(w, (u32x4*)(rowp + bj * 128)); } }
    }
};
struct EpiGate {
    static constexpr bool PERM = false, AFTER_DRAIN = false, KEEP_ACC = true;
    const bf16_t* proj; bf16_t* mb; int nM;
    __device__ __forceinline__ void operator()(f32x4 (&acc)[2][2][4][2], const Unit& u, int wr, int wc, int fr, int fq) const {
        const int b = u.pm / nM, pm = u.pm - b * nM, pn = u.pn & 3;
        const bf16_t* gt = proj + (size_t)(20 + 4 * b + pn) * PTILE; const bf16_t* gt2 = gt + (b < 2 ? 4 * PTILE : (size_t)0);
        const int row0 = pm * 256 + wr * 64 + fr, colin = wc * 32 + 4 * fq;
#pragma unroll
        for (int ai = 0; ai < 2; ++ai) { u32x2 gw[4][2][2], hw[4][2][2];
#pragma unroll
            for (int m = 0; m < 4; ++m)
#pragma unroll
                for (int bj = 0; bj < 2; ++bj)
#pragma unroll
                    for (int n = 0; n < 2; ++n) { const size_t go = (size_t)(row0 + ai * 128 + m * 16) * 256 + colin + bj * 128 + n * 16;
                        gw[m][bj][n] = *(const u32x2*)(gt + go); hw[m][bj][n] = *(const u32x2*)(gt2 + go); }
#pragma unroll
            for (int m = 0; m < 4; ++m)
#pragma unroll
                for (int bj = 0; bj < 2; ++bj)
#pragma unroll
                    for (int n = 0; n < 2; ++n) { const int r = row0 + ai * 128 + m * 16, cin = colin + bj * 128 + n * 16; const u32x2 g = gw[m][bj][n], hh = hw[m][bj][n];
                        f32x4 f; f[0] = __builtin_amdgcn_rcpf(1.0f + __expf(-bf2f(g.x & 0xffffu))); f[1] = __builtin_amdgcn_rcpf(1.0f + __expf(-bf2f(g.x >> 16)));
                        f[2] = __builtin_amdgcn_rcpf(1.0f + __expf(-bf2f(g.y & 0xffffu))); f[3] = __builtin_amdgcn_rcpf(1.0f + __expf(-bf2f(g.y >> 16)));
                        if (b < 2) { f[0] *= 1.0f + __expf(-bf2f(hh.x & 0xffffu)); f[1] *= 1.0f + __expf(-bf2f(hh.x >> 16)); f[2] *= 1.0f + __expf(-bf2f(hh.y & 0xffffu)); f[3] *= 1.0f + __expf(-bf2f(hh.y >> 16)); }
                        const f32x4 v = acc[ai][bj][m][n] * f;
                        if (b < 2) acc[ai][bj][m][n] = v;
                        else { u32x2 w; w.x = pk2(v[0], v[1]); w.y = pk2(v[2], v[3]); *(u32x2*)(mb + (size_t)r * 1024 + pn * 256 + cin) = w; acc[ai][bj][m][n] = (f32x4){0.f, 0.f, 0.f, 0.f}; } }
            asm volatile("" ::: "memory"); }
    }
};
struct EpiResid {
    static constexpr bool PERM = false, AFTER_DRAIN = false, KEEP_ACC = false;
    float* x;
    __device__ __forceinline__ void operator()(const f32x4 (&acc)[2][2][4][2], const Unit& u, int wr, int wc, int fr, int fq) const {
        const int row0 = u.pm * 256 + wr * 64 + fr, col0 = u.pn * 256 + wc * 32 + 4 * fq;
#pragma unroll
        for (int ai = 0; ai < 2; ++ai) { f32x4 old[4][2][2];
#pragma unroll
            for (int m = 0; m < 4; ++m)
#pragma unroll
                for (int bj = 0; bj < 2; ++bj)
#pragma unroll
                    for (int n = 0; n < 2; ++n) old[m][bj][n] = *(const f32x4*)(x + (size_t)(row0 + ai * 128 + m * 16) * 1024 + col0 + bj * 128 + n * 16);
#pragma unroll
            for (int m = 0; m < 4; ++m)
#pragma unroll
                for (int bj = 0; bj < 2; ++bj)
#pragma unroll
                    for (int n = 0; n < 2; ++n) *(f32x4*)(x + (size_t)(row0 + ai * 128 + m * 16) * 1024 + col0 + bj * 128 + n * 16) = old[m][bj][n] + acc[ai][bj][m][n];
            asm volatile("" ::: "memory"); }
    }
};
struct BranchOrder {
    int nM, G, c;
    __device__ __forceinline__ bool next(int i, Unit& u) const {
        const int c8 = (G % 8 == 0) ? (c % 8) * (G / 8) + c / 8 : c;
        const int tile = c8 + (i / 3) * G, b = i % 3; if (tile >= nM * 4) return false;
        u.pm = b * nM + (tile >> 2); u.pn = b * 4 + (tile & 3); return true; }
    __device__ __forceinline__ void a_ready(const Unit&) const {}
    __device__ __forceinline__ void done(const Unit&) const {}
};

__device__ __forceinline__ void cvt_tile(const float* __restrict__ src, int ldsrc, int k0, int c0, int valid, bf16_t* __restrict__ dst, int lddst, int r0, LAS float* tile, int tid) {
    const int kk = tid >> 3, seg = (tid & 7) * 8;
    float4 a = make_float4(0.f, 0.f, 0.f, 0.f), b = a;
    if (seg + 8 <= valid) { const f32x4* p = (const f32x4*)(src + (size_t)(k0 + kk) * ldsrc + c0 + seg); const f32x4 a4 = __builtin_nontemporal_load(p), b4 = __builtin_nontemporal_load(p + 1);
        a = make_float4(a4[0], a4[1], a4[2], a4[3]); b = make_float4(b4[0], b4[1], b4[2], b4[3]); }
    LAS float* t = tile + kk * 65 + seg;
    t[0] = a.x; t[1] = a.y; t[2] = a.z; t[3] = a.w; t[4] = b.x; t[5] = b.y; t[6] = b.z; t[7] = b.w;
    __syncthreads();
    const int n = tid >> 3, ks = (tid & 7) * 8;
    const LAS float* s = tile + ks * 65 + n;
    u32x4 w; w.x = pk2(s[0], s[65]); w.y = pk2(s[2 * 65], s[3 * 65]); w.z = pk2(s[4 * 65], s[5 * 65]); w.w = pk2(s[6 * 65], s[7 * 65]);
    *(u32x4*)(dst + (size_t)(r0 + n) * lddst + k0 + ks) = w;
    __syncthreads();
}
__device__ __forceinline__ void cvt_tile_lr(const float* __restrict__ win_l, const float* __restrict__ upw_d, int dir, int k0, int c0, bf16_t* __restrict__ dst, int r0, LAS float* tile, int tid) {
    const int kk = tid >> 3, seg = (tid & 7) * 8;
    const float4* wr = (const float4*)(win_l + (size_t)(k0 + kk) * NIN + 4096 + dir * 16);
    const float4 w0 = wr[0], w1 = wr[1], w2 = wr[2], w3 = wr[3];
    const float wv[16] = {w0.x, w0.y, w0.z, w0.w, w1.x, w1.y, w1.z, w1.w, w2.x, w2.y, w2.z, w2.w, w3.x, w3.y, w3.z, w3.w};
    float o[8] = {0.f, 0.f, 0.f, 0.f, 0.f, 0.f, 0.f, 0.f};
#pragma unroll
    for (int r = 0; r < 16; ++r) { const float4* up = (const float4*)(upw_d + (size_t)r * 256 + c0 + seg); const float4 a = up[0], b = up[1];
        o[0] += wv[r] * a.x; o[1] += wv[r] * a.y; o[2] += wv[r] * a.z; o[3] += wv[r] * a.w; o[4] += wv[r] * b.x; o[5] += wv[r] * b.y; o[6] += wv[r] * b.z; o[7] += wv[r] * b.w; }
    LAS float* t = tile + kk * 65 + seg;
#pragma unroll
    for (int j = 0; j < 8; ++j) t[j] = o[j];
    __syncthreads();
    const int n = tid >> 3, ks = (tid & 7) * 8;
    const LAS float* s = tile + ks * 65 + n;
    u32x4 w; w.x = pk2(s[0], s[65]); w.y = pk2(s[2 * 65], s[3 * 65]); w.z = pk2(s[4 * 65], s[5 * 65]); w.w = pk2(s[6 * 65], s[7 * 65]);
    *(u32x4*)(dst + (size_t)(r0 + n) * DM + k0 + ks) = w;
    __syncthreads();
}
__device__ __forceinline__ void convert_phase(LAS unsigned char* lds, const Params& p, int l) {
    LAS float* tile = (LAS float*)lds; int tid_ = threadIdx.x; asm volatile("" : "+v"(tid_)); const int tid = tid_; unsigned char* ws = p.ws;
    for (int it = blockIdx.x * NTHR + tid; it < 16384; it += gridDim.x * NTHR) {
        const int lane = it & 63, ks = (it >> 6) & 1, nt = (it >> 7) & 3, mat = (it >> 9) & 1, w = (it >> 10) & 7, dir = it >> 13;
        const float* src = (mat ? p.in[13] : p.in[11]) + (size_t)((l * 2 + dir) * 8 + w) * 4096;
        float v[8];
#pragma unroll
        for (int e = 0; e < 8; ++e) v[e] = src[(ks * 32 + (lane >> 4) * 8 + e) * 64 + nt * 16 + (lane & 15)];
        u32x4 o; o.x = pk2(v[0], v[1]); o.y = pk2(v[2], v[3]); o.z = pk2(v[4], v[5]); o.w = pk2(v[6], v[7]);
        *(u32x4*)((bf16_t*)(ws + WS_RGW) + (size_t)it * 8) = o;
    }
    for (int idx = blockIdx.x; idx < 4928; idx += gridDim.x) {
        int i = idx;
        if (i < 2048) { const int nb = i % 128, kb = i / 128, r0 = nb * 64; const int c0 = (r0 < 4096) ? r0 : r0 + 32;
            cvt_tile(p.in[3] + (size_t)l * DM * NIN, NIN, kb * 64, c0, 64, (bf16_t*)(ws + WS_WIN), DM, r0, tile, tid); continue; }
        i -= 2048;
        if (i < 128) { const int dir = i >> 6, cb = (i >> 4) & 3, kb = i & 15;
            cvt_tile_lr(p.in[3] + (size_t)l * DM * NIN, p.in[6] + (size_t)(l * 2 + dir) * 16 * 256, dir, kb * 64, cb * 64, (bf16_t*)(ws + WS_WIN), 8192 + dir * 256 + cb * 64, tile, tid); continue; }
        i -= 128;
        if (i < 384) { const int b = i / 128, rem = i % 128, nb = rem % 16, kb = rem / 16;
            cvt_tile(p.in[16] + (size_t)(l * 3 + b) * 512 * DM, DM, kb * 64, nb * 64, 64, (bf16_t*)(ws + WS_WB) + (size_t)b * DM * 512, 512, nb * 64, tile, tid); continue; }
        i -= 384;
        if (i < 256) { const int nb = i % 16, kb = i / 16;
            cvt_tile(p.in[17] + (size_t)l * DM * DM, DM, kb * 64, nb * 64, 64, (bf16_t*)(ws + WS_WOUT), DM, nb * 64, tile, tid); continue; }
        i -= 256;
        if (i < 1408) { const int nb = i % 88, kb = i / 88;
            cvt_tile(p.in[19] + (size_t)l * DM * 2 * DFF, 2 * DFF, kb * 64, nb * 64, 64, (bf16_t*)(ws + WS_WUP), DM, nb * 64, tile, tid); continue; }
        i -= 1408;
        { const int nb = i % 16, kb = i / 16;
            cvt_tile(p.in[22] + (size_t)l * DFF * DM, DM, kb * 64, nb * 64, 64, (bf16_t*)(ws + WS_WDN), DFF, nb * 64, tile, tid); }
    }
}

__device__ __forceinline__ void norm_phase(const float* __restrict__ src, float* xcopy, const float* __restrict__ w, bf16_t* hb, int nrows) {
    int tid_ = threadIdx.x; asm volatile("" : "+v"(tid_));
    const int lane = tid_ & 63, wv = blockIdx.x * 8 + (tid_ >> 6), nwv = gridDim.x * 8;
    float4 wv4[4];
#pragma unroll
    for (int j = 0; j < 4; ++j) wv4[j] = ((const float4*)w)[lane + 64 * j];
    for (int row = wv; row < nrows; row += nwv) {
        const float4* pr = (const float4*)(src + (size_t)row * DM); float4 v[4]; float ss = 0.f;
#pragma unroll
        for (int j = 0; j < 4; ++j) { v[j] = pr[lane + 64 * j]; ss += v[j].x * v[j].x + v[j].y * v[j].y + v[j].z * v[j].z + v[j].w * v[j].w; }
        ss = wave_sum(ss); const float rs = rsqrtf(ss * (1.0f / DM) + EPS);
#pragma unroll
        for (int j = 0; j < 4; ++j) { u32x2 o; o.x = pk2(v[j].x * rs * wv4[j].x, v[j].y * rs * wv4[j].y); o.y = pk2(v[j].z * rs * wv4[j].z, v[j].w * rs * wv4[j].w);
            *(u32x2*)(hb + (size_t)row * DM + (lane + 64 * j) * 4) = o;
            if (xcopy) ((float4*)(xcopy + (size_t)row * DM))[lane + 64 * j] = v[j]; }
    }
}
__device__ __forceinline__ void final_norm_phase(float* x, const float* __restrict__ w, int nrows) {
    int tid_ = threadIdx.x; asm volatile("" : "+v"(tid_));
    const int lane = tid_ & 63, wv = blockIdx.x * 8 + (tid_ >> 6), nwv = gridDim.x * 8;
    float4 wv4[4];
#pragma unroll
    for (int j = 0; j < 4; ++j) wv4[j] = ((const float4*)w)[lane + 64 * j];
    for (int row = wv; row < nrows; row += nwv) {
        float4* pr = (float4*)(x + (size_t)row * DM); float4 v[4]; float ss = 0.f;
#pragma unroll
        for (int j = 0; j < 4; ++j) { v[j] = pr[lane + 64 * j]; ss += v[j].x * v[j].x + v[j].y * v[j].y + v[j].z * v[j].z + v[j].w * v[j].w; }
        ss = wave_sum(ss); const float rs = rsqrtf(ss * (1.0f / DM) + EPS);
#pragma unroll
        for (int j = 0; j < 4; ++j) pr[lane + 64 * j] = make_float4(v[j].x * rs * wv4[j].x, v[j].y * rs * wv4[j].y, v[j].z * rs * wv4[j].z, v[j].w * rs * wv4[j].w);
    }
}

__device__ __forceinline__ float row16_sum(float v) {
    v += __builtin_bit_cast(float, __builtin_amdgcn_update_dpp(0, __builtin_bit_cast(int, v), 0x128, 0xf, 0xf, false));
    v += __builtin_bit_cast(float, __builtin_amdgcn_update_dpp(0, __builtin_bit_cast(int, v), 0x124, 0xf, 0xf, false));
    v += __builtin_bit_cast(float, __builtin_amdgcn_update_dpp(0, __builtin_bit_cast(int, v), 0x122, 0xf, 0xf, false));
    v += __builtin_bit_cast(float, __builtin_amdgcn_update_dpp(0, __builtin_bit_cast(int, v), 0x121, 0xf, 0xf, false));
    return v;
}
#define WAVE_LDS_FENCE() asm volatile("" ::: "memory")
#define LDS_BARRIER() do { asm volatile("s_waitcnt lgkmcnt(0)" ::: "memory"); __builtin_amdgcn_s_barrier(); asm volatile("" ::: "memory"); } while (0)
#define MFMA16(a, b, c) __builtin_amdgcn_mfma_f32_16x16x32_bf16((a), (b), (c), 0, 0, 0)
typedef short bf16x4 __attribute__((ext_vector_type(4)));
#define MFMA16K16(a, b, c) __builtin_amdgcn_mfma_f32_16x16x16bf16_1k((a), (b), (c), 0, 0, 0)
constexpr int GC_STRIDE = 17408, GC_KD = 4352, GC_KTT = 8704, GC_VT = 12800, GC_DEC = 16896;
constexpr int GN_STB = 4 * GC_STRIDE, GN_ATT = GN_STB + 8 * 4352, GN_SSQ = GN_ATT + 8 * 512, GN_DSUM = GN_SSQ + 2048, GN_END = GN_DSUM + 2048;
static_assert(GN_END <= 131072, "GLA LDS map fits");

template <bool ISA, bool OUT>
__device__ __forceinline__ void gla_item(LAS unsigned char* lds, const Params& p, const int l, const int item, unsigned long long* tt) {
    constexpr int DK = ISA ? 128 : 64, DKP = 136, NKS = DK / 32, NNT = DK / 16;
    int tid_ = threadIdx.x; asm volatile("" : "+v"(tid_));
    const int tid = tid_, lane = tid & 63, wid = __builtin_amdgcn_readfirstlane(tid >> 6);
    const int s = item >> 6, h = (item >> 4) & 3, sc = item & 15;
    const int rowbase = s * SEQ + sc * LSC;
    const int l15 = lane & 15, lq = lane >> 4, e0 = wid * 16;
    const int ck = wid >> 1, hh = wid & 1;
    const bool prepqk = ISA || hh == 0;
    const int d = ISA ? hh * 64 + lane : lane, ev = hh * 64 + lane;
    unsigned char* ws = p.ws;
    const bf16_t* proj = (const bf16_t*)(ws + WS_PROJ);
    LAS bf16_t* STB = (LAS bf16_t*)(lds + GN_STB + wid * 4352); LAS bf16_t* ATT = (LAS bf16_t*)(lds + GN_ATT + wid * 512);
    LAS float* SSQ = (LAS float*)(lds + GN_SSQ); LAS float* DSUM = (LAS float*)(lds + GN_DSUM);
    const size_t hoff = (size_t)(h >> 1) * PTILE + (h & 1) * 128;
    const bf16_t* qT = ISA ? proj + hoff : proj + 10 * PTILE + h * 64;
    const bf16_t* vT = proj + (ISA ? 6 : 12) * PTILE + hoff;
    const bf16_t* ogT = proj + (ISA ? 8 : 14) * PTILE + hoff;
    const float qscale = ISA ? 0.08838834764831845f : 0.125f;
    float* ofw = (float*)(ws + (ISA ? WS_H : WS_OFB));
    bf16_t* oout = (bf16_t*)(ws + WS_O) + (ISA ? (size_t)0 : (size_t)MG * 512);
    const float nw = (ISA ? p.in[5] : p.in[8])[l * 128 + e0 + l15];
#pragma unroll 1
    for (int dir = 0; dir < 2; ++dir) {
    const bf16_t* zT = ISA ? proj + (size_t)(2 + 2 * dir) * PTILE + hoff : proj + 11 * PTILE + h * 64;
    const bf16_t* yT = proj + (size_t)(32 + dir) * PTILE + h * 64;
    const int shd = (s * 4 + h) * 2 + dir;
    float* Sg = (float*)(ws + (ISA ? WS_SA : WS_SB)) + ((size_t)shd * NSC + sc) * (size_t)(128 * DK);
    float* Dg = (float*)(ws + (ISA ? WS_DA : WS_DB)) + ((size_t)shd * NSC + sc) * DK;

    float lb = 0.f, upb = 0.f;
    if (ISA) { const int c = h * 128 + d; float x[4], mx = -1e30f;
#pragma unroll
        for (int q = 0; q < 4; ++q) { x[q] = p.in[4][(q * 2 + dir) * 512 + c]; mx = fmaxf(mx, x[q]); }
        float den = 0.f, num = 0.f;
#pragma unroll
        for (int q = 0; q < 4; ++q) { const float ex = __expf(x[q] - mx); den += ex; if (q >= 1 && q <= l) num += ex; }
        lb = num * __builtin_amdgcn_rcpf(den);
    } else upb = p.in[7][(l * 2 + dir) * 256 + h * 64 + d];
    f32x4 ST[NNT];
#pragma unroll
    for (int nt = 0; nt < NNT; ++nt)
#pragma unroll
        for (int r = 0; r < 4; ++r) ST[nt][r] = OUT ? Sg[(size_t)(e0 + lq * 4 + r) * DK + nt * 16 + l15] : 0.f;
    if (OUT) {
#pragma unroll
        for (int nt = 0; nt < NNT; ++nt)
#pragma unroll
            for (int r = 0; r < 4; ++r) STB[(lq * 4 + r) * DKP + nt * 16 + l15] = (bf16_t)f2bf(ST[nt][r]);
    }
    float dsum = 1.f;
    unsigned zr[16];
#define GLA_LOADRAW(SSI) do { const int pos0_ = (SSI) * 64 + ck * 16;     \
        _Pragma("unroll") for (int j = 0; j < 16; ++j) { const size_t ro_ = (size_t)(rowbase + (dir ? (LSC - 1) - (pos0_ + j) : pos0_ + j)) * 256; \
            zr[j] = (unsigned)zT[ro_ + d]; } \
        __builtin_amdgcn_sched_barrier(0); } while (0)
    GLA_LOADRAW(0);
    __syncthreads();

#pragma unroll 1
    for (int ssi = 0; ssi < LSC / 64; ++ssi) {
#ifdef PROBE_STAGES
        unsigned long long ts0 = __builtin_amdgcn_s_memrealtime();
#endif
        { LAS unsigned char* cb = lds + ck * GC_STRIDE;
          LAS bf16_t* QD = (LAS bf16_t*)cb; LAS bf16_t* KD = (LAS bf16_t*)(cb + GC_KD); LAS bf16_t* KTT = (LAS bf16_t*)(cb + GC_KTT); LAS bf16_t* VT = (LAS bf16_t*)(cb + GC_VT); LAS float* DEC = (LAS float*)(cb + GC_DEC);
          unsigned qr[16], vr[16], yr[16];
          { const int pos0_ = ssi * 64 + ck * 16;
#pragma unroll
            for (int j = 0; j < 16; ++j) { const size_t ro_ = (size_t)(rowbase + (dir ? (LSC - 1) - (pos0_ + j) : pos0_ + j)) * 256; qr[j] = OUT ? (unsigned)qT[ro_ + d] : 0u; yr[j] = ISA ? 0u : (unsigned)yT[ro_ + d]; }
            __builtin_amdgcn_sched_barrier(0); }
#define VLOAD() do { const int pv0_ = ssi * 64 + ck * 16; _Pragma("unroll") for (int j = 0; j < 16; ++j) vr[j] = (unsigned)vT[(size_t)(rowbase + (dir ? (LSC - 1) - (pv0_ + j) : pv0_ + j)) * 256 + ev]; __builtin_amdgcn_sched_barrier(0); } while (0)
          VLOAD();
          if (prepqk) {
            float gf[16], kk[16], qs[16], etot = 1.f;
#pragma unroll
            for (int j = 0; j < 16; ++j) { const float a = bf2f(zr[j]);
                if (ISA) { const float sg = sigmoidf_(a); gf[j] = lb + (1.f - lb) * sg; kk[j] = (1.f - lb) * (1.f - sg); const float q = bf2f(qr[j]); qs[j] = q * sigmoidf_(q) * qscale; }
                else { const float y = bf2f(yr[j]) + upb;
                    gf[j] = __builtin_amdgcn_exp2f((fminf(y, 0.f) * 1.4426950408889634f - __builtin_amdgcn_logf(1.f + __expf(-fabsf(y)))) * 0.0625f); kk[j] = a; qs[j] = bf2f(qr[j]) * qscale; }
                etot *= gf[j]; }
            float eb = 1.f, kt[16];
#pragma unroll
            for (int j = 0; j < 16; ++j) { eb *= gf[j];
                const float ebi = __builtin_amdgcn_rcpf(eb);
                if (OUT) { QD[j * DKP + d] = (bf16_t)f2bf(qs[j] * eb); KD[j * DKP + d] = (bf16_t)f2bf(kk[j] * ebi); }
                kt[j] = kk[j] * (etot * ebi); }
            u32x4 w0, w1; w0.x = pk2(kt[0], kt[1]); w0.y = pk2(kt[2], kt[3]); w0.z = pk2(kt[4], kt[5]); w0.w = pk2(kt[6], kt[7]);
            w1.x = pk2(kt[8], kt[9]); w1.y = pk2(kt[10], kt[11]); w1.z = pk2(kt[12], kt[13]); w1.w = pk2(kt[14], kt[15]);
            *(LAS u32x4*)(KTT + d * 16) = w0; *(LAS u32x4*)(KTT + d * 16 + 8) = w1;
            DEC[d] = etot; dsum *= etot;
          }
          u32x4 v0, v1; v0.x = vr[0] | (vr[1] << 16); v0.y = vr[2] | (vr[3] << 16); v0.z = vr[4] | (vr[5] << 16); v0.w = vr[6] | (vr[7] << 16);
          v1.x = vr[8] | (vr[9] << 16); v1.y = vr[10] | (vr[11] << 16); v1.z = vr[12] | (vr[13] << 16); v1.w = vr[14] | (vr[15] << 16);
          *(LAS u32x4*)(VT + ev * 16) = v0; *(LAS u32x4*)(VT + ev * 16 + 8) = v1; }
#ifdef PROBE_STAGES
        { const unsigned long long t1 = __builtin_amdgcn_s_memrealtime(); tt[0] += t1 - ts0; ts0 = t1; }
#endif
        LDS_BARRIER();
#ifdef PROBE_STAGES
        { const unsigned long long t1 = __builtin_amdgcn_s_memrealtime(); tt[1] += t1 - ts0; ts0 = t1; }
#endif
        f32x4 ofv[4], os[4];
        if (OUT && dir == 1) {
#pragma unroll
            for (int kq = 0; kq < 4; ++kq)
#pragma unroll
                for (int r = 0; r < 4; ++r) { const size_t row = (size_t)(rowbase + (LSC - 1) - (ssi * 64 + kq * 16 + lq * 4 + r));
                    ofv[kq][r] = ofw[row * 512 + h * 128 + e0 + l15]; }
        }
        if (ssi < LSC / 64 - 1) GLA_LOADRAW(ssi + 1);
#pragma unroll
        for (int kq = 0; kq < 4; ++kq) {
            const int pos0 = ssi * 64 + kq * 16;
            LAS unsigned char* cb = lds + kq * GC_STRIDE;
            const LAS bf16_t* QD = (const LAS bf16_t*)cb; const LAS bf16_t* KD = (const LAS bf16_t*)(cb + GC_KD); const LAS bf16_t* KTT = (const LAS bf16_t*)(cb + GC_KTT);
            const LAS bf16_t* VT = (const LAS bf16_t*)(cb + GC_VT); const LAS float* DEC = (const LAS float*)(cb + GC_DEC);
            bf16x8 aq[NKS];
            const bf16x4 vt = *(const LAS bf16x4*)(VT + (e0 + l15) * 16 + lq * 4);
            f32x4 o = {0.f, 0.f, 0.f, 0.f};
            if (OUT) {
                f32x4 att = {0.f, 0.f, 0.f, 0.f};
#pragma unroll
                for (int ks = 0; ks < NKS; ++ks) { aq[ks] = *(const LAS bf16x8*)(QD + l15 * DKP + ks * 32 + lq * 8);
                    const bf16x8 bk = *(const LAS bf16x8*)(KD + l15 * DKP + ks * 32 + lq * 8); att = MFMA16(aq[ks], bk, att); }
#pragma unroll
                for (int r = 0; r < 4; ++r) { const int i = lq * 4 + r; const bool keep = l15 <= i; ATT[i * 16 + l15] = keep ? (bf16_t)f2bf(att[r]) : (bf16_t)0; }
                WAVE_LDS_FENCE();
                const bf16x4 aatt = *(const LAS bf16x4*)(ATT + l15 * 16 + lq * 4);
                __builtin_amdgcn_s_setprio(1);
                o = MFMA16K16(aatt, vt, o);
#pragma unroll
                for (int ks = 0; ks < NKS; ++ks) { const bf16x8 bst = *(const LAS bf16x8*)(STB + l15 * DKP + ks * 32 + lq * 8); o = MFMA16(aq[ks], bst, o); }
            }
#pragma unroll
            for (int nt = 0; nt < NNT; ++nt) { const bf16x4 bkt = *(const LAS bf16x4*)(KTT + (nt * 16 + l15) * 16 + lq * 4);
                if (!OUT && nt == 0) __builtin_amdgcn_s_setprio(1);
                const float dec = DEC[nt * 16 + l15]; ST[nt] = MFMA16K16(vt, bkt, ST[nt] * dec); }
            __builtin_amdgcn_s_setprio(0);
            if (OUT) {
                WAVE_LDS_FENCE();
#pragma unroll
                for (int nt = 0; nt < NNT; ++nt)
#pragma unroll
                    for (int r = 0; r < 4; ++r) STB[(lq * 4 + r) * DKP + nt * 16 + l15] = (bf16_t)f2bf(ST[nt][r]);
                if (dir == 0) {
#pragma unroll
                    for (int r = 0; r < 4; ++r) ofw[(size_t)(rowbase + pos0 + lq * 4 + r) * 512 + h * 128 + e0 + l15] = o[r];
                } else {
                    os[kq] = o + ofv[kq];
#pragma unroll
                    for (int r = 0; r < 4; ++r) { float v = os[kq][r] * os[kq][r]; v = row16_sum(v);
                        if (l15 == 0) SSQ[(kq * 16 + lq * 4 + r) * 8 + wid] = v; }
                }
            }
        }
#ifdef PROBE_STAGES
        { const unsigned long long t1 = __builtin_amdgcn_s_memrealtime(); tt[2] += t1 - ts0; ts0 = t1; }
#endif
        LDS_BARRIER();
#ifdef PROBE_STAGES
        { const unsigned long long t1 = __builtin_amdgcn_s_memrealtime(); tt[3] += t1 - ts0; ts0 = t1; }
#endif
        if (OUT && dir == 1) {
            unsigned ogv[4][4];
#pragma unroll
            for (int kq = 0; kq < 4; ++kq)
#pragma unroll
                for (int r = 0; r < 4; ++r) ogv[kq][r] = ogT[(size_t)(rowbase + (LSC - 1) - (ssi * 64 + kq * 16 + lq * 4 + r)) * 256 + e0 + l15];
#pragma unroll
            for (int kq = 0; kq < 4; ++kq)
#pragma unroll
                for (int r = 0; r < 4; ++r) { const int i = lq * 4 + r; const size_t row = (size_t)(rowbase + (LSC - 1) - (ssi * 64 + kq * 16 + i));
                    const f32x4 a = *(const LAS f32x4*)(SSQ + (kq * 16 + i) * 8), b = *(const LAS f32x4*)(SSQ + (kq * 16 + i) * 8 + 4);
                    const float tot = (a[0] + a[1]) + (a[2] + a[3]) + (b[0] + b[1]) + (b[2] + b[3]); const float rs = rsqrtf(tot * (1.0f / 128.0f) + EPS);
                    const float og = bf2f(ogv[kq][r]); const float val = os[kq][r] * rs * nw * og * sigmoidf_(og);
                    oout[row * 512 + h * 128 + e0 + l15] = (bf16_t)f2bf(val); }
        }
    }
#undef GLA_LOADRAW
#undef VLOAD
    if (!OUT) {
#pragma unroll
        for (int nt = 0; nt < NNT; ++nt)
#pragma unroll
            for (int r = 0; r < 4; ++r) Sg[(size_t)(e0 + lq * 4 + r) * DK + nt * 16 + l15] = ST[nt][r];
        if (prepqk) DSUM[ck * 128 + d] = dsum;
        __syncthreads();
        if (tid < DK) Dg[tid] = (DSUM[tid] * DSUM[128 + tid]) * (DSUM[256 + tid] * DSUM[384 + tid]);
    }
    __syncthreads();
    }
}
template <bool OUT>
__device__ __forceinline__ void rglru_item(LAS unsigned char* lds, const Params& p, const int l, const int item) {
    int tid_ = threadIdx.x; asm volatile("" : "+v"(tid_));
    const int tid = tid_, lane = tid & 63, w = __builtin_amdgcn_readfirstlane(tid >> 6);
    const int s = item >> 7, scc = item & 127, tb = scc * LCC;
    const int l15 = lane & 15, lq = lane >> 4, c = 64 * w + lane;
    unsigned char* ws = p.ws;
    const bf16_t* proj = (const bf16_t*)(ws + WS_PROJ);
    LAS bf16_t* XC = (LAS bf16_t*)(lds + w * 15360); LAS float* AS = (LAS float*)(lds + w * 15360 + 9216); LAS bf16_t* US = (LAS bf16_t*)(lds + w * 15360 + 9216 + 4096);
    const bf16_t* xT = proj + (size_t)(16 + (w >> 2)) * PTILE + (w & 3) * 64 + lane;
    const bf16_t* yT = proj + (size_t)(18 + (w >> 2)) * PTILE + (w & 3) * 64 + lane;
    bf16_t* oc = (bf16_t*)(ws + WS_O) + (size_t)2 * MG * 512;
    float* CH = (float*)(ws + WS_CH); float* CP = (float*)(ws + WS_CP);
    const float cw0 = p.in[9][(l * 4 + 0) * 512 + c], cw1 = p.in[9][(l * 4 + 1) * 512 + c], cw2 = p.in[9][(l * 4 + 2) * 512 + c], cw3 = p.in[9][(l * 4 + 3) * 512 + c], cb = p.in[10][l * 512 + c];
    {
        float xin[67];
#pragma unroll
        for (int i = 0; i < 67; ++i) { const int t = tb - 2 + i; const int tc = t < 0 ? 0 : (t >= SEQ ? SEQ - 1 : t); const float xx = bf2f((unsigned)xT[(size_t)(s * SEQ + tc) * 256]); xin[i] = (t == tc) ? xx : 0.f; }
#pragma unroll
        for (int i = 0; i < 64; ++i) XC[i * 72 + lane] = (bf16_t)f2bf(cb + cw0 * xin[i] + cw1 * xin[i + 1] + cw2 * xin[i + 2] + cw3 * xin[i + 3]);
    }
#pragma unroll 1
    for (int dir = 0; dir < 2; ++dir) {
        bf16x8 wfa[4][2], wfx[4][2]; float ba[4], bx[4], sp[4];
        { const bf16_t* rgw = (const bf16_t*)(ws + WS_RGW);
#pragma unroll
            for (int nt = 0; nt < 4; ++nt) {
#pragma unroll
                for (int ks = 0; ks < 2; ++ks) { wfa[nt][ks] = *(const bf16x8*)(rgw + (size_t)((((dir * 8 + w) * 2 + 0) * 4 + nt) * 2 + ks) * 512 + lane * 8);
                    wfx[nt][ks] = *(const bf16x8*)(rgw + (size_t)((((dir * 8 + w) * 2 + 1) * 4 + nt) * 2 + ks) * 512 + lane * 8); }
                const int cj = (l * 2 + dir) * 512 + 64 * w + nt * 16 + l15;
                ba[nt] = p.in[12][cj]; bx[nt] = p.in[14][cj]; const float lam = p.in[15][cj];
                sp[nt] = fmaxf(-lam, 0.f) + __logf(1.f + __expf(-fabsf(lam)));
            } }
        const size_t cidx = ((size_t)(s * NCC + scc) * 2 + dir) * 512 + c;
        float hst = OUT ? CH[cidx] : 0.f, pprod = 1.f;
#pragma unroll 1
        for (int sbi = 0; sbi < 4; ++sbi) {
            const int sb = dir ? 3 - sbi : sbi, t0 = tb + 16 * sb;
            LAS bf16_t* XCS = XC + (t0 - tb) * 72;
            unsigned hv[16], yv[16];
            if (OUT && dir == 1) {
#pragma unroll
                for (int i = 0; i < 16; ++i) { const size_t row = (size_t)(s * SEQ + t0 + i); hv[i] = (unsigned)oc[row * 512 + c]; yv[i] = (unsigned)yT[row * 256]; }
                __builtin_amdgcn_sched_barrier(0);
            }
            WAVE_LDS_FENCE();
            f32x4 accr[4], acci[4];
            const bf16x8 af0 = *(const LAS bf16x8*)(XCS + l15 * 72 + lq * 8), af1 = *(const LAS bf16x8*)(XCS + l15 * 72 + 32 + lq * 8);
            __builtin_amdgcn_s_setprio(1);
#pragma unroll
            for (int nt = 0; nt < 4; ++nt) { f32x4 z = {0.f, 0.f, 0.f, 0.f};
                accr[nt] = MFMA16(af0, wfa[nt][0], z); accr[nt] = MFMA16(af1, wfa[nt][1], accr[nt]);
                acci[nt] = MFMA16(af0, wfx[nt][0], z); acci[nt] = MFMA16(af1, wfx[nt][1], acci[nt]); }
            __builtin_amdgcn_s_setprio(0);
#pragma unroll
            for (int nt = 0; nt < 4; ++nt)
#pragma unroll
                for (int r = 0; r < 4; ++r) { const int t = lq * 4 + r, jj = nt * 16 + l15;
                    const float rr = sigmoidf_(accr[nt][r] + ba[nt]), ii = sigmoidf_(acci[nt][r] + bx[nt]);
                    const float la = -8.0f * rr * sp[nt]; const float a = __expf(la); const float mult = __builtin_amdgcn_sqrtf(fmaxf(fmaf(-a, a, 1.0f), 0.f));
                    AS[t * 64 + jj] = a; US[t * 64 + jj] = (bf16_t)f2bf(mult * ii * bf2f((unsigned)XCS[t * 72 + jj])); }
            WAVE_LDS_FENCE();
            if (dir == 0) {
#pragma unroll
                for (int i = 0; i < 16; ++i) { const float a = AS[i * 64 + lane], u = bf2f((unsigned)US[i * 64 + lane]); hst = a * hst + u; pprod *= a;
                    if (OUT) oc[(size_t)(s * SEQ + t0 + i) * 512 + c] = (bf16_t)f2bf(hst); }
            } else {
#pragma unroll
                for (int i2 = 0; i2 < 16; ++i2) { const int i = 15 - i2; const float a = AS[i * 64 + lane], u = bf2f((unsigned)US[i * 64 + lane]); hst = a * hst + u; pprod *= a;
                    if (OUT) oc[(size_t)(s * SEQ + t0 + i) * 512 + c] = (bf16_t)f2bf((bf2f(hv[i]) + hst) * gelu_tanh(bf2f(yv[i]))); }
            }
            WAVE_LDS_FENCE();
        }
        if (!OUT) { CH[cidx] = hst; CP[cidx] = pprod; }
    }
}

__device__ __forceinline__ void scan_phase(const Params& p) {
    unsigned char* ws = p.ws;
    int tid_ = threadIdx.x; asm volatile("" : "+v"(tid_));
    const int gtid = blockIdx.x * NTHR + tid_, nthr = gridDim.x * NTHR;
    constexpr int NA = GS * 4 * 2 * 128 * 128, NB = GS * 4 * 2 * 128 * 64;
    for (int idx = gtid; idx < NA + NB; idx += nthr) {
        const bool isa = idx < NA; const int i = isa ? idx : idx - NA; const int per = isa ? 16384 : 8192, dk = isa ? 128 : 64;
        const int shd = i / per, ed = i - shd * per, d = ed & (dk - 1), dir = shd & 1;
        float* S = (float*)(ws + (isa ? WS_SA : WS_SB)) + (size_t)shd * NSC * per + ed;
        const float* D = (const float*)(ws + (isa ? WS_DA : WS_DB)) + (size_t)shd * NSC * dk + d;
        float cur = 0.f;
        { float tmp[NSC], dd[NSC];
#pragma unroll
            for (int k = 0; k < NSC; ++k) { const int sc = dir ? NSC - 1 - k : k; tmp[k] = S[(size_t)sc * per]; dd[k] = D[(size_t)sc * dk]; }
#pragma unroll
            for (int k = 0; k < NSC; ++k) { const int sc = dir ? NSC - 1 - k : k; S[(size_t)sc * per] = cur; cur = cur * dd[k] + tmp[k]; }
        }
    }
    if (gtid < GS * 2 * 512) {
        const int s = gtid >> 10, dir = (gtid >> 9) & 1, c = gtid & 511;
        float* CH = (float*)(ws + WS_CH); const float* CP = (const float*)(ws + WS_CP);
        float cur = 0.f;
#pragma unroll 1
        for (int q = 0; q < NCC; q += 32) {
            float tmp[32], dd[32];
#pragma unroll
            for (int k = 0; k < 32; ++k) { const int scc = dir ? NCC - 1 - (q + k) : q + k; const size_t ix = ((size_t)(s * NCC + scc) * 2 + dir) * 512 + c; tmp[k] = CH[ix]; dd[k] = CP[ix]; }
#pragma unroll
            for (int k = 0; k < 32; ++k) { const int scc = dir ? NCC - 1 - (q + k) : q + k; const size_t ix = ((size_t)(s * NCC + scc) * 2 + dir) * 512 + c; CH[ix] = cur; cur = cur * dd[k] + tmp[k]; }
        }
    }
}

__device__ __forceinline__ float bfe(const u32x4& v, int e) { const unsigned wd = (e >> 1) == 0 ? v.x : (e >> 1) == 1 ? v.y : (e >> 1) == 2 ? v.z : v.w; return (e & 1) ? bf2f(wd >> 16) : bf2f(wd & 0xffffu); }
__device__ __forceinline__ void convgelu_phase(const Params& p, const int l) {
    unsigned char* ws = p.ws;
    const bf16_t* __restrict__ u = (const bf16_t*)(ws + WS_PROJ); bf16_t* __restrict__ g = (bf16_t*)(ws + WS_O);
    int tid_ = threadIdx.x; asm volatile("" : "+v"(tid_));
    const int gtid = blockIdx.x * NTHR + tid_, nthr = gridDim.x * NTHR;
    const float* cw = p.in[20] + (size_t)l * 3 * 2 * DFF; const float* cbias = p.in[21] + (size_t)l * 2 * DFF;
    constexpr int NCG = DFF / 8, RUN = 16;
    for (int it = gtid; it < NCG * (MG / RUN); it += nthr) {
        const int cg8 = it % NCG, run = it / NCG, c = cg8 * 8, row0 = run * RUN, t0 = row0 & (SEQ - 1);
        float wg[3][8], wv[3][8], bg[8], bv[8];
#pragma unroll
        for (int j = 0; j < 3; ++j)
#pragma unroll
            for (int e = 0; e < 8; ++e) { wg[j][e] = cw[(size_t)j * 2 * DFF + c + e]; wv[j][e] = cw[(size_t)j * 2 * DFF + DFF + c + e]; }
#pragma unroll
        for (int e = 0; e < 8; ++e) { bg[e] = cbias[c + e]; bv[e] = cbias[DFF + c + e]; }
        const u32x4 z4 = {0, 0, 0, 0};
        u32x4 pg = z4, pv = z4, cg_, cv_;
        { const size_t rp = (size_t)(t0 > 0 ? row0 - 1 : row0) * (2 * DFF); pg = __builtin_nontemporal_load((const u32x4*)(u + rp + c)); pv = __builtin_nontemporal_load((const u32x4*)(u + rp + DFF + c)); if (t0 == 0) { pg = z4; pv = z4; } }
        cg_ = __builtin_nontemporal_load((const u32x4*)(u + (size_t)row0 * (2 * DFF) + c)); cv_ = __builtin_nontemporal_load((const u32x4*)(u + (size_t)row0 * (2 * DFF) + DFF + c));
#pragma unroll 4
        for (int i = 0; i < RUN; ++i) {
            u32x4 ng = z4, nv = z4;
            { const bool has = t0 + i + 1 < SEQ; const size_t rn = (size_t)(has ? row0 + i + 1 : row0 + i) * (2 * DFF); ng = __builtin_nontemporal_load((const u32x4*)(u + rn + c)); nv = __builtin_nontemporal_load((const u32x4*)(u + rn + DFF + c)); if (!has) { ng = z4; nv = z4; } }
            float o[8];
#pragma unroll
            for (int e = 0; e < 8; ++e) { const float a = bg[e] + wg[0][e] * bfe(pg, e) + wg[1][e] * bfe(cg_, e) + wg[2][e] * bfe(ng, e);
                const float b = bv[e] + wv[0][e] * bfe(pv, e) + wv[1][e] * bfe(cv_, e) + wv[2][e] * bfe(nv, e); o[e] = gelu_tanh(a) * b; }
            u32x4 w4; w4.x = pk2(o[0], o[1]); w4.y = pk2(o[2], o[3]); w4.z = pk2(o[4], o[5]); w4.w = pk2(o[6], o[7]);
            *(u32x4*)(g + (size_t)(row0 + i) * DFF + c) = w4;
            pg = cg_; pv = cv_; cg_ = ng; cv_ = nv;
        }
    }
}

#ifndef REP_M1
#define REP_M1 1
#endif
#ifndef REP_M3
#define REP_M3 1
#endif
#ifndef REP_MISC
#define REP_MISC 1
#endif
#ifndef REP_RG
#define REP_RG 1
#endif
#ifndef REP_G1
#define REP_G1 1
#endif
#ifndef REP_G5
#define REP_G5 1
#endif
#define PB_G1 1
#define PB_M1 2
#define PB_M2 3
#define PB_M3 4
#define PB_G3 5
#define PB_G4 6
#define PB_N 7
#define PB_G5 8
#define PB_CONV 9
#define PB_G6 10
#ifndef PROBE_A
#define PROBE_A(c) ((c) == PB_M1 || (c) == PB_M3)
#endif
#ifndef PROBE_B
#define PROBE_B(c) ((c) == PB_G1 || (c) == PB_G3 || (c) == PB_G4 || (c) == PB_G5 || (c) == PB_G6)
#endif
__global__ void __launch_bounds__(NTHR, 2) mega_fwd(Params p) {
    extern __shared__ __attribute__((aligned(16))) unsigned char lds_raw[];
    LAS unsigned char* lds = (LAS unsigned char*)lds_raw;
    cg::grid_group grid = cg::this_grid();
    volatile LAS unsigned* bst = (volatile LAS unsigned*)(lds + 131072);
    if (threadIdx.x < 2) bst[threadIdx.x] = 0u;
    __syncthreads();
    const XcdBarrier bar = xcd_barrier_post((unsigned*)(p.ws + WS_BAR), bst);
    unsigned char* ws = p.ws;
    const int G = gridDim.x, bid = blockIdx.x;
    bf16_t* hbuf = (bf16_t*)(ws + WS_H);
    bf16_t* proj = (bf16_t*)(ws + WS_PROJ);

#pragma unroll 1
    for (int l = 0; l < DEPTH; ++l) {
        convert_phase(lds, p, l);
        if (l == 0) grid.sync(); else xcd_barrier(bar);
#pragma unroll 1
        for (int grp = 0; grp < NGRP; ++grp) {
            float* xg = p.out + (size_t)grp * MG * DM;
#pragma unroll 1
            for (int ph_ = 0; ph_ < 11; ++ph_) {
                int ph = ph_; asm volatile("" : "+s"(ph));
                if (ph == 0) {
                    if (grp > 0) continue;
                    if (l == 0) norm_phase(p.in[0], xg, p.in[2] + l * DM, hbuf, MG);
                    else norm_phase(xg, nullptr, p.in[2] + l * DM, hbuf, MG);
                } else if (ph == 1 || ph == 8) {
                    const bool up = ph == 8; const int N = up ? 2 * DFF : NINP;
                    Gemm g{hbuf, (const bf16_t*)(ws + (up ? WS_WUP : WS_WIN)), MG, N, DM}; pg8::StaticOrder S; S.init(MG, N, G, bid);
                    EpiStoreBf16 E{proj, up ? 2 * DFF : 256, up ? 0 : 1}; pg8::gemm_phase<EpiStoreBf16, pg8::StaticOrder>(lds, g, S, E);
                } else if (ph == 2) {
                    for (int it = bid; it < 256; it += G) { if (it < 128) gla_item<true, false>(lds, p, l, it, nullptr); else gla_item<false, false>(lds, p, l, it - 128, nullptr); rglru_item<false>(lds, p, l, it); __syncthreads(); }
                } else if (ph == 3) {
                    scan_phase(p);
                } else if (ph == 4) {
                    for (int it = bid; it < 256; it += G) { if (it < 128) gla_item<true, true>(lds, p, l, it, nullptr); else gla_item<false, true>(lds, p, l, it - 128, nullptr); rglru_item<true>(lds, p, l, it); __syncthreads(); }
                } else if (ph == 5) {
                    Gemm g{(const bf16_t*)(ws + WS_O), (const bf16_t*)(ws + WS_WB), 3 * MG, 3 * DM, 512}; BranchOrder S{MG / 256, G, bid};
                    EpiGate E{proj, hbuf, MG / 256}; pg8::gemm_phase<EpiGate, BranchOrder>(lds, g, S, E);
                } else if (ph == 6 || ph == 10) {
                    const bool dn = ph == 10;
                    Gemm g{dn ? (const bf16_t*)(ws + WS_O) : (const bf16_t*)hbuf, (const bf16_t*)(ws + (dn ? WS_WDN : WS_WOUT)), MG, DM, dn ? DFF : DM}; pg8::StaticOrder S; S.init(MG, DM, G, bid);
                    EpiResid E{xg}; pg8::gemm_phase<EpiResid, pg8::StaticOrder>(lds, g, S, E);
                    if (dn && grp + 1 < NGRP) {
                        float* xn = p.out + (size_t)(grp + 1) * MG * DM;
                        if (l == 0) norm_phase(p.in[1] + (size_t)grp * MG * DM, xn, p.in[2] + l * DM, hbuf, MG);
                        else norm_phase(xn, nullptr, p.in[2] + l * DM, hbuf, MG); }
                } else if (ph == 7) {
                    norm_phase(xg, nullptr, p.in[18] + l * DM, hbuf, MG);
                } else {
                    convgelu_phase(p, l);
                }
                xcd_barrier(bar);
            }
        }
    }
    final_norm_phase(p.out, p.in[23], NSEQ * SEQ);
}

extern "C" void kernel_launch(void* const* d_in, const int* in_sizes, int n_in, void* d_out, int out_size, void* d_ws, size_t ws_size, hipStream_t stream) {
    static int grid = 0;
    if (grid == 0) {
        if (n_in != 24 || ws_size < WS_END) { fprintf(stderr, "kernel_launch: need 24 inputs and %zu bytes of workspace (got %d, %zu)\n", (size_t)WS_END, n_in, ws_size); grid = -1; return; }
        int dev = 0, cus = 0, per_cu = 0;
        hipGetDevice(&dev); hipDeviceGetAttribute(&cus, hipDeviceAttributeMultiprocessorCount, dev);
        hipFuncSetAttribute((const void*)mega_fwd, hipFuncAttributeMaxDynamicSharedMemorySize, LDS_BYTES);
        hipOccupancyMaxActiveBlocksPerMultiprocessor(&per_cu, (const void*)mega_fwd, NTHR, LDS_BYTES);
        if (per_cu < 1) { fprintf(stderr, "kernel_launch: occupancy query says 0 blocks per CU\n"); per_cu = 1; }
        grid = cus;
        (void)hipGetLastError();
    }
    if (grid < 0) return;
    if (hipMemsetAsync((char*)d_ws + WS_BAR, 0, XCD_BAR_WORDS * 4, stream) != hipSuccess) { fprintf(stderr, "kernel_launch: memset of the barrier words failed\n"); return; }
    Params p{};
    for (int i = 0; i < 24; ++i) p.in[i] = (const float*)d_in[i];
    p.out = (float*)d_out; p.ws = (unsigned char*)d_ws;
    void* args[] = {&p};
    hipError_t e = hipLaunchCooperativeKernel((const void*)mega_fwd, dim3(grid), dim3(NTHR), args, LDS_BYTES, stream);
    if (e != hipSuccess) fprintf(stderr, "cooperative launch failed: %s (grid %d)\n", hipGetErrorString(e), grid);
}
```

```cpp
#include <hip/hip_runtime.h>
#include <hip/hip_cooperative_groups.h>
#include <cstdio>
namespace cg = cooperative_groups;

#define LAS __attribute__((address_space(3)))
typedef unsigned short bf16_t;
typedef short bf16x8 __attribute__((ext_vector_type(8)));
typedef float f32x4 __attribute__((ext_vector_type(4)));
typedef float f32x2 __attribute__((ext_vector_type(2)));
typedef unsigned u32x4 __attribute__((ext_vector_type(4)));
typedef unsigned u32x2 __attribute__((ext_vector_type(2)));

constexpr int DM = 1024, SEQ = 8192, NSEQ = 6, DEPTH = 4;
constexpr int GS = 2;
constexpr int MG = GS * SEQ;
constexpr int NGRP = NSEQ / GS;
constexpr int NIN = 8224, NINP = 8704;
constexpr int DFF = 2816;
constexpr int LSC = 512, NSC = SEQ / LSC;
constexpr int NSCA = 32;
constexpr int LCC = 64, NCC = SEQ / LCC;
constexpr int NTHR = 512;
constexpr int LDS_BYTES = 131072 + 256;
constexpr float EPS = 1e-6f;

constexpr size_t WS_WIN  = 0;
constexpr size_t WS_WB   = WS_WIN  + (size_t)NINP * DM * 2;
constexpr size_t WS_WOUT = WS_WB   + (size_t)3 * DM * 512 * 2;
constexpr size_t WS_WUP  = WS_WOUT + (size_t)DM * DM * 2;
constexpr size_t WS_WDN  = WS_WUP  + (size_t)2 * DFF * DM * 2;
constexpr size_t WS_H    = WS_WDN  + (size_t)DM * DFF * 2;
constexpr size_t WS_PROJ = WS_H    + (size_t)MG * DM * 2;
constexpr size_t PTILE   = (size_t)MG * 256;
constexpr size_t WS_O    = WS_PROJ + 34 * PTILE * 2;
constexpr size_t WS_SA   = WS_O    + (size_t)3 * MG * 512 * 2;
constexpr size_t WS_SB   = WS_SA   + (size_t)GS * 4 * 2 * NSCA * 128 * 128 * 4;
constexpr size_t WS_DA   = WS_SB   + (size_t)GS * 4 * 2 * NSCA * 128 * 64 * 4;
constexpr size_t WS_DB   = WS_DA   + (size_t)GS * 4 * 2 * NSCA * 128 * 4;
constexpr size_t WS_CH   = WS_DB   + (size_t)GS * 4 * 2 * NSCA * 64 * 4;
constexpr size_t WS_CP   = WS_CH   + (size_t)GS * NCC * 2 * 512 * 4;
constexpr size_t WS_BAR  = WS_CP   + (size_t)GS * NCC * 2 * 512 * 4;
constexpr size_t WS_RGW  = WS_BAR  + 16384;
constexpr size_t WS_OFB  = WS_RGW  + 262144;
constexpr size_t WS_END  = WS_OFB  + (size_t)MG * 512 * 4;
static_assert((size_t)MG * 2 * DFF * 2 <= 34 * PTILE * 2, "u buffer fits the projection region");
static_assert((size_t)MG * DFF * 2 <= WS_DA - WS_O, "g buffer fits o + state region");

struct Params { const float* in[24]; float* out; unsigned char* ws; };

__device__ __forceinline__ float bf2f(unsigned b) { return __uint_as_float(b << 16); }
typedef __bf16 bf16v2_t __attribute__((ext_vector_type(2)));
__device__ __forceinline__ unsigned pk2(float lo, float hi) { const f32x2 f = {lo, hi}; const bf16v2_t v = __builtin_convertvector(f, bf16v2_t); return __builtin_bit_cast(unsigned, v); }
__device__ __forceinline__ unsigned f2bf(float f) { return pk2(f, f) & 0xffffu; }
__device__ __forceinline__ float sigmoidf_(float x) { return __builtin_amdgcn_rcpf(1.0f + __expf(-x)); }
__device__ __forceinline__ float gelu_tanh(float x) { const float t = 1.5957691216057308f * (x + 0.044715f * x * x * x); return x * __builtin_amdgcn_rcpf(1.0f + __expf(-t)); }
__device__ __forceinline__ float wave_sum(float v) {
#pragma unroll
    for (int o = 32; o >= 1; o >>= 1) v += __shfl_xor(v, o);
    return v;
}

namespace pg8 {
#define PG8_LAS __attribute__((address_space(3)))
typedef unsigned short bf16_t;
typedef short bf16x8 __attribute__((ext_vector_type(8)));
typedef float f32x4 __attribute__((ext_vector_type(4)));
typedef unsigned u32x4 __attribute__((ext_vector_type(4)));
constexpr int BM = 256, BK = 64, HALF = 128, HTB = HALF * BK * 2  , STAGE_BYTES = 8 * HTB, NXCD = 8, WGM = 8;

__host__ __device__ __forceinline__ int lds_byte(int r, int c) { const int st = (r >> 4) * 2 + (c >> 5), rr = r & 15, cc = c & 31, ob = rr * 64 + cc * 2; return st * 1024 + (ob ^ (((ob >> 9) & 1) << 5)); }
__host__ __device__ __forceinline__ void stage_rc(int b, int& R, int& C) { const int st = b / 1024, sb = b % 1024, swz = sb ^ (((sb >> 9) & 1) << 5); R = (st >> 1) * 16 + swz / 64; C = (st & 1) * 32 + (swz % 64) / 2; }
__host__ __device__ __forceinline__ int perm32(int rho) { const int n = rho >> 4, i = rho & 15; return 8 * (i >> 2) + 4 * n + (i & 3); }

struct Unit { int pm, pn; };
struct Gemm { const bf16_t* A; const bf16_t* Bt; int M, N, K; };

struct StaticOrder {
    int nM, nN, nwg, G, c;
    __host__ __device__ void init(int M, int N, int G_, int c_) { nM = M / BM; nN = N / BM; nwg = nM * nN; G = G_; c = c_; }
    __host__ __device__ bool next(int i, Unit& u) const {
        const long L = (long)i * G + c; if (L >= nwg) return false;
        int wgid = (int)L; { const int q = nwg / NXCD, r = nwg % NXCD, xcd = wgid % NXCD, off = wgid / NXCD; wgid = (xcd < r ? xcd * (q + 1) : r * (q + 1) + (xcd - r) * q) + off; }
        const int nig = WGM * nN, gid = wgid / nig, fm = gid * WGM, gsz = (nM - fm) < WGM ? (nM - fm) : WGM;
        u.pm = fm + ((wgid % nig) % gsz); u.pn = (wgid % nig) / gsz; return true;
    }
    __device__ __forceinline__ void a_ready(const Unit&) const {}
    __device__ __forceinline__ void done(const Unit&) const {}
};
__device__ __forceinline__ unsigned cvt_pk_bf16(float lo, float hi) { return ::pk2(lo, hi); }
typedef float f32x2 __attribute__((ext_vector_type(2)));
template <class Epi, class Sched>
__device__ __forceinline__ void gemm_phase(PG8_LAS unsigned char* lds, const Gemm g, const Sched& S, const Epi& E) {
    int tid_ = threadIdx.x; asm volatile("" : "+v"(tid_));
    const int tid = tid_, wid = __builtin_amdgcn_readfirstlane(tid >> 6), lane = tid & 63, wr = wid >> 2, wc = wid & 3, fr = lane & 15, fq = lane >> 4;
    int K_ = g.K; asm volatile("" : "+s"(K_));
    const int K = K_, nt = K / BK;
    unsigned voffA[2], voffB[2];
#pragma unroll
    for (int i = 0; i < 2; ++i) { int R, C; stage_rc(tid * 16 + i * 8192, R, C); const int Rb = Epi::PERM ? ((R & ~31) + perm32(R & 31)) : R;
        voffA[i] = (unsigned)(R * K + C) * 2u; voffB[i] = (unsigned)(Rb * K + C) * 2u; }
    const size_t kstep = (size_t)(BK * 2);
    const size_t hstep = (size_t)HALF * K * 2;
    const size_t tstep = 2 * hstep;
    const unsigned ldsw = (unsigned)wid * 1024u;
    const int aoff = lds_byte(wr * 64 + fr, fq * 8), boff = lds_byte(wc * 32 + fr, fq * 8);
#define PG8_SA(b, h) (((b) * 2 + (h)) * HTB)
#define PG8_SB(b, h) ((4 + (b) * 2 + (h)) * HTB)
#define PG8_STAGE(bufoff, gbase, voff) do { _Pragma("unroll") for (int _i = 0; _i < 2; ++_i) \
        __builtin_amdgcn_global_load_lds((const unsigned*)((const char*)(gbase) + (voff)[_i]), (PG8_LAS unsigned*)(lds + (bufoff) + ldsw + _i * 8192), 16, 0, 0); } while (0)
#define PG8_LDA(dst, b, h) do { _Pragma("unroll") for (int m = 0; m < 4; ++m) _Pragma("unroll") for (int k = 0; k < 2; ++k) dst[m][k] = *(const PG8_LAS bf16x8*)(lds + PG8_SA(b, h) + aoff + m * 2048 + k * 1024); } while (0)
#define PG8_LDB(dst, b, h) do { _Pragma("unroll") for (int n = 0; n < 2; ++n) _Pragma("unroll") for (int k = 0; k < 2; ++k) dst[n][k] = *(const PG8_LAS bf16x8*)(lds + PG8_SB(b, h) + boff + n * 2048 + k * 1024); } while (0)
#define PG8_MMA(ai, bj, At, Bt) do { __builtin_amdgcn_s_setprio(1); _Pragma("unroll") for (int m = 0; m < 4; ++m) _Pragma("unroll") for (int n = 0; n < 2; ++n) _Pragma("unroll") for (int k = 0; k < 2; ++k) \
        acc[ai][bj][m][n] = __builtin_amdgcn_mfma_f32_16x16x32_bf16(Bt[n][k], At[m][k], acc[ai][bj][m][n], 0, 0, 0); __builtin_amdgcn_s_setprio(0); } while (0)
#define PG8_WAIT_V(n) asm volatile("s_waitcnt vmcnt(" #n ")" ::: "memory")
#define PG8_WAIT_L(n) asm volatile("s_waitcnt lgkmcnt(" #n ")" ::: "memory")
#define PG8_BAR __builtin_amdgcn_s_barrier()
#define PG8_SCHED __builtin_amdgcn_sched_barrier(0)
    Unit cur, nxt; int ui = 0;
    if (!S.next(0, cur)) return;
    f32x4 acc[2][2][4][2];
#pragma unroll
    for (int a = 0; a < 2; ++a)
#pragma unroll
        for (int b = 0; b < 2; ++b)
#pragma unroll
            for (int m = 0; m < 4; ++m)
#pragma unroll
                for (int n = 0; n < 2; ++n) acc[a][b][m][n] = (f32x4){0.f, 0.f, 0.f, 0.f};
    bf16x8 At[4][2], B0[2][2], B1[2][2];
    const char* cA = (const char*)g.A + (size_t)cur.pm * tstep; const char* cB = (const char*)g.Bt + (size_t)cur.pn * tstep;
    S.a_ready(cur);
    PG8_STAGE(PG8_SB(0, 0), cB, voffB); PG8_STAGE(PG8_SA(0, 0), cA, voffA); PG8_STAGE(PG8_SB(0, 1), cB + hstep, voffB); PG8_STAGE(PG8_SA(0, 1), cA + hstep, voffA);
    if (wr == 1) PG8_BAR;
    PG8_WAIT_V(4); PG8_BAR;
    PG8_STAGE(PG8_SB(1, 0), cB + kstep, voffB); PG8_STAGE(PG8_SA(1, 0), cA + kstep, voffA); PG8_STAGE(PG8_SB(1, 1), cB + hstep + kstep, voffB);
    PG8_WAIT_V(6); PG8_BAR;
    for (;;) {
        const bool has_next = S.next(ui + 1, nxt);
        const char* nA = has_next ? (const char*)g.A + (size_t)nxt.pm * tstep : cA; const char* nB = has_next ? (const char*)g.Bt + (size_t)nxt.pn * tstep : cB;
#pragma unroll 1
        for (int t = 0; t < nt; t += 2) {
            const bool last = (t == nt - 2);
            const char* a1 = cA + (size_t)(t + 1) * kstep;
            const char* a2 = last ? nA : cA + (size_t)(t + 2) * kstep; const char* b2 = last ? nB : cB + (size_t)(t + 2) * kstep;
            const char* a3 = a2 + kstep; const char* b3 = b2 + kstep;
            if (last && has_next) S.a_ready(nxt);
            PG8_LDB(B0, 0, 0); PG8_SCHED; PG8_LDA(At, 0, 0); PG8_STAGE(PG8_SA(1, 1), a1 + hstep, voffA);
            PG8_WAIT_L(8); PG8_BAR; PG8_WAIT_L(0); PG8_MMA(0, 0, At, B0); PG8_BAR; PG8_SCHED;
            PG8_LDB(B1, 0, 1); PG8_STAGE(PG8_SB(0, 0), b2, voffB);
            PG8_BAR; PG8_WAIT_L(0); PG8_MMA(0, 1, At, B1); PG8_BAR;
            PG8_LDA(At, 0, 1); PG8_STAGE(PG8_SA(0, 0), a2, voffA);
            PG8_BAR; PG8_WAIT_L(0); PG8_MMA(1, 0, At, B0); PG8_BAR; PG8_SCHED;
            PG8_STAGE(PG8_SB(0, 1), b2 + hstep, voffB);
            PG8_WAIT_V(6); PG8_BAR; PG8_MMA(1, 1, At, B1); PG8_BAR;
            PG8_LDB(B0, 1, 0); PG8_SCHED; PG8_LDA(At, 1, 0); PG8_STAGE(PG8_SA(0, 1), a2 + hstep, voffA);
            PG8_WAIT_L(8); PG8_BAR; PG8_WAIT_L(0); PG8_MMA(0, 0, At, B0); PG8_BAR; PG8_SCHED;
            PG8_LDB(B1, 1, 1); PG8_STAGE(PG8_SB(1, 0), b3, voffB);
            PG8_BAR; PG8_WAIT_L(0); PG8_MMA(0, 1, At, B1); PG8_BAR;
            PG8_LDA(At, 1, 1); PG8_STAGE(PG8_SA(1, 0), a3, voffA);
            PG8_BAR; PG8_WAIT_L(0); PG8_MMA(1, 0, At, B0); PG8_BAR; PG8_SCHED;
            PG8_STAGE(PG8_SB(1, 1), b3 + hstep, voffB);
            PG8_WAIT_V(6); PG8_BAR; PG8_MMA(1, 1, At, B1); PG8_BAR;
        }
        if constexpr (!Epi::AFTER_DRAIN) { E(acc, cur, wr, wc, fr, fq); S.done(cur); }
        if (!has_next) break;
        if constexpr (!Epi::KEEP_ACC)
#pragma unroll
        for (int a = 0; a < 2; ++a)
#pragma unroll
            for (int b = 0; b < 2; ++b)
#pragma unroll
                for (int m = 0; m < 4; ++m)
#pragma unroll
                    for (int n = 0; n < 2; ++n) acc[a][b][m][n] = (f32x4){0.f, 0.f, 0.f, 0.f};
        cur = nxt; cA = nA; cB = nB; ++ui;
    }
    PG8_WAIT_V(0);
    if (wr == 0) PG8_BAR;
    PG8_BAR;
    if constexpr (Epi::AFTER_DRAIN) { E.fused(acc, cur, wr, wc, fr, fq, lds, wid, lane); S.done(cur); }
#undef PG8_SA
#undef PG8_SB
#undef PG8_STAGE
#undef PG8_LDA
#undef PG8_LDB
#undef PG8_MMA
#undef PG8_WAIT_V
#undef PG8_WAIT_L
#undef PG8_BAR
#undef PG8_SCHED
}
}
#define XB_TMO      128
#define XB_XCNT(j)  (256  + 64 * (j))
#define XB_XSUB(j)  (1280 + 64 * (j))
#define XB_XGEN(j)  (2304 + 64 * (j))
#define XB_TOP      3328
#define XB_TOPGEN   3392
#define XCD_BAR_WORDS 3456
#define XB_SPIN_CAP (1u << 18)

__device__ __forceinline__ unsigned xb_ld(unsigned* p)              { return __hip_atomic_load(p, __ATOMIC_RELAXED, __HIP_MEMORY_SCOPE_AGENT); }
__device__ __forceinline__ unsigned xb_add(unsigned* p, unsigned v) { return __hip_atomic_fetch_add(p, v, __ATOMIC_RELAXED, __HIP_MEMORY_SCOPE_AGENT); }
__device__ __forceinline__ unsigned xb_xcc_id() { return (unsigned)__builtin_amdgcn_s_getreg((3 << 11) | 20) & 0xFu; }
#define XB_SPIN(cond, bar) do { unsigned _sp = 0; while (cond) { __builtin_amdgcn_s_sleep(1); \
    if ((++_sp & 255u) == 0u) { if (xb_ld(&(bar)[XB_TMO])) break; if (_sp > XB_SPIN_CAP) { atomicAdd(&(bar)[XB_TMO], 1u); break; } } } } while (0)

struct XcdBarrier {
    unsigned* bar; unsigned x;
    volatile LAS unsigned* st;
};

__device__ __forceinline__ XcdBarrier xcd_barrier_post(unsigned* bar, volatile LAS unsigned* st) {
    XcdBarrier b; b.bar = bar; b.x = xb_xcc_id(); b.st = st;
    if (threadIdx.x == 0) (void)xb_add(&bar[XB_XCNT(b.x)], 1u);
    return b;
}
__device__ __forceinline__ void xcd_barrier_complete(unsigned* bar, unsigned x, unsigned& nloc, unsigned& nx) {
    const unsigned G = gridDim.x * gridDim.y * gridDim.z;
    unsigned sum, cnt, mine, sp = 0u;
    for (;;) {
        sum = 0u; cnt = 0u; mine = 0u;
#pragma unroll
        for (unsigned j = 0; j < 16; ++j) { const unsigned c = xb_ld(&bar[XB_XCNT(j)]); sum += c; cnt += (c > 0u) ? 1u : 0u; mine = (j == x) ? c : mine; }
        if (sum == G) break;
        __builtin_amdgcn_s_sleep(1);
        if ((++sp & 255u) == 0u) { if (xb_ld(&bar[XB_TMO])) break; if (sp > XB_SPIN_CAP) { atomicAdd(&bar[XB_TMO], 1u); break; } }
    }
    nloc = mine > 0u ? mine : 1u; nx = cnt > 0u ? cnt : 1u;
}

__device__ __forceinline__ void xcd_barrier(const XcdBarrier& b) {
    asm volatile("s_waitcnt vmcnt(0)" ::: "memory");
    __syncthreads();
    if (threadIdx.x == 0) {
        unsigned* bar = b.bar;
        __builtin_amdgcn_s_waitcnt(0);
        unsigned nloc = b.st[0], nx = b.st[1];
        if (nloc == 0u) { xcd_barrier_complete(bar, b.x, nloc, nx); b.st[0] = nloc; b.st[1] = nx; }
        const unsigned old = xb_add(&bar[XB_XSUB(b.x)], 1u);
        const unsigned gen = old / nloc;
        if (old + 1u == (gen + 1u) * nloc) {
            __builtin_amdgcn_fence(__ATOMIC_RELEASE, "agent");
            asm volatile("s_waitcnt vmcnt(0)" ::: "memory");
            const unsigned og = xb_add(&bar[XB_TOP], 1u);
            const unsigned tg = og / nx;
            if (og + 1u == (tg + 1u) * nx) xb_add(&bar[XB_TOPGEN], 1u);
            else XB_SPIN(xb_ld(&bar[XB_TOPGEN]) == tg, bar);
            __builtin_amdgcn_fence(__ATOMIC_ACQUIRE, "agent");
            xb_add(&bar[XB_XGEN(b.x)], 1u);
            asm volatile("s_waitcnt vmcnt(0)" ::: "memory");
        } else {
            XB_SPIN(xb_ld(&bar[XB_XGEN(b.x)]) == gen, bar);
            __builtin_amdgcn_fence(__ATOMIC_ACQUIRE, "agent");
            asm volatile("s_waitcnt vmcnt(0)" ::: "memory");
        }
    }
    __syncthreads();
}

using pg8::Unit; using pg8::Gemm;

struct EpiStoreBf16 {
    static constexpr bool PERM = true, AFTER_DRAIN = false, KEEP_ACC = false;
    bf16_t* O; int ldc; int tile_major;
    __device__ __forceinline__ void operator()(const f32x4 (&acc)[2][2][4][2], const Unit& u, int wr, int wc, int fr, int fq) const {
        const int row0 = u.pm * 256 + wr * 64 + fr; bf16_t* base = O; int colt = u.pn * 256;
        if (tile_major) { base += (size_t)u.pn * PTILE; colt = 0; }
        const int col0 = colt + wc * 32 + 8 * fq;
#pragma unroll
        for (int ai = 0; ai < 2; ++ai)
#pragma unroll
            for (int m = 0; m < 4; ++m) { bf16_t* rowp = base + (size_t)(row0 + ai * 128 + m * 16) * ldc + col0;
#pragma unroll
                for (int bj = 0; bj < 2; ++bj) { const f32x4 v0 = acc[ai][bj][m][0], v1 = acc[ai][bj][m][1];
                    u32x4 w; w.x = pg8::cvt_pk_bf16(v0[0], v0[1]); w.y = pg8::cvt_pk_bf16(v0[2], v0[3]); w.z = pg8::cvt_pk_bf16(v1[0], v1[1]); w.w = pg8::cvt_pk_bf16(v1[2], v1[3]);
                    __builtin_nontemporal_store(w, (u32x4*)(rowp + bj * 128)); } }
    }
};
struct EpiGate {
    static constexpr bool PERM = false, AFTER_DRAIN = false, KEEP_ACC = true;
    const bf16_t* proj; bf16_t* mb; int nM;
    __device__ __forceinline__ void operator()(f32x4 (&acc)[2][2][4][2], const Unit& u, int wr, int wc, int fr, int fq) const {
        const int b = u.pm / nM, pm = u.pm - b * nM, pn = u.pn & 3;
        const bf16_t* gt = proj + (size_t)(20 + 4 * b + pn) * PTILE; const bf16_t* gt2 = gt + (b < 2 ? 4 * PTILE : (size_t)0);
        const int row0 = pm * 256 + wr * 64 + fr, colin = wc * 32 + 4 * fq;
#pragma unroll
        for (int ai = 0; ai < 2; ++ai) { u32x2 gw[4][2][2], hw[4][2][2];
#pragma unroll
            for (int m = 0; m < 4; ++m)
#pragma unroll
                for (int bj = 0; bj < 2; ++bj)
#pragma unroll
                    for (int n = 0; n < 2; ++n) { const size_t go = (size_t)(row0 + ai * 128 + m * 16) * 256 + colin + bj * 128 + n * 16;
                        gw[m][bj][n] = *(const u32x2*)(gt + go); hw[m][bj][n] = *(const u32x2*)(gt2 + go); }
#pragma unroll
            for (int m = 0; m < 4; ++m)
#pragma unroll
                for (int bj = 0; bj < 2; ++bj)
#pragma unroll
                    for (int n = 0; n < 2; ++n) { const int r = row0 + ai * 128 + m * 16, cin = colin + bj * 128 + n * 16; const u32x2 g = gw[m][bj][n], hh = hw[m][bj][n];
                        f32x4 f; f[0] = __builtin_amdgcn_rcpf(1.0f + __expf(-bf2f(g.x & 0xffffu))); f[1] = __builtin_amdgcn_rcpf(1.0f + __expf(-bf2f(g.x >> 16)));
                        f[2] = __builtin_amdgcn_rcpf(1.0f + __expf(-bf2f(g.y & 0xffffu))); f[3] = __builtin_amdgcn_rcpf(1.0f + __expf(-bf2f(g.y >> 16)));
                        if (b < 2) { f[0] *= 1.0f + __expf(-bf2f(hh.x & 0xffffu)); f[1] *= 1.0f + __expf(-bf2f(hh.x >> 16)); f[2] *= 1.0f + __expf(-bf2f(hh.y & 0xffffu)); f[3] *= 1.0f + __expf(-bf2f(hh.y >> 16)); }
                        const f32x4 v = acc[ai][bj][m][n] * f;
                        if (b < 2) acc[ai][bj][m][n] = v;
                        else { u32x2 w; w.x = pk2(v[0], v[1]); w.y = pk2(v[2], v[3]); *(u32x2*)(mb + (size_t)r * 1024 + pn * 256 + cin) = w; acc[ai][bj][m][n] = (f32x4){0.f, 0.f, 0.f, 0.f}; } }
            asm volatile("" ::: "memory"); }
    }
};
struct EpiResid {
    static constexpr bool PERM = false, AFTER_DRAIN = false, KEEP_ACC = false;
    float* x;
    __device__ __forceinline__ void operator()(const f32x4 (&acc)[2][2][4][2], const Unit& u, int wr, int wc, int fr, int fq) const {
        const int row0 = u.pm * 256 + wr * 64 + fr, col0 = u.pn * 256 + wc * 32 + 4 * fq;
#pragma unroll
        for (int ai = 0; ai < 2; ++ai) { f32x4 old[4][2][2];
#pragma unroll
            for (int m = 0; m < 4; ++m)
#pragma unroll
                for (int bj = 0; bj < 2; ++bj)
#pragma unroll
                    for (int n = 0; n < 2; ++n) old[m][bj][n] = *(const f32x4*)(x + (size_t)(row0 + ai * 128 + m * 16) * 1024 + col0 + bj * 128 + n * 16);
#pragma unroll
            for (int m = 0; m < 4; ++m)
#pragma unroll
                for (int bj = 0; bj < 2; ++bj)
#pragma unroll
                    for (int n = 0; n < 2; ++n) *(f32x4*)(x + (size_t)(row0 + ai * 128 + m * 16) * 1024 + col0 + bj * 128 + n * 16) = old[m][bj][n] + acc[ai][bj][m][n];
            asm volatile("" ::: "memory"); }
    }
};
struct BranchOrder {
    int nM, G, c;
    __device__ __forceinline__ bool next(int i, Unit& u) const {
        const int c8 = (G % 8 == 0) ? (c % 8) * (G / 8) + c / 8 : c;
        const int tile = c8 + (i / 3) * G, b = i % 3; if (tile >= nM * 4) return false;
        u.pm = b * nM + (tile >> 2); u.pn = b * 4 + (tile & 3); return true; }
    __device__ __forceinline__ void a_ready(const Unit&) const {}
    __device__ __forceinline__ void done(const Unit&) const {}
};

__device__ __forceinline__ void cvt_tile(const float* __restrict__ src, int ldsrc, int k0, int c0, int valid, bf16_t* __restrict__ dst, int lddst, int r0, LAS float* tile, int tid) {
    const int kk = tid >> 3, seg = (tid & 7) * 8;
    float4 a = make_float4(0.f, 0.f, 0.f, 0.f), b = a;
    if (seg + 8 <= valid) { const f32x4* p = (const f32x4*)(src + (size_t)(k0 + kk) * ldsrc + c0 + seg); const f32x4 a4 = __builtin_nontemporal_load(p), b4 = __builtin_nontemporal_load(p + 1);
        a = make_float4(a4[0], a4[1], a4[2], a4[3]); b = make_float4(b4[0], b4[1], b4[2], b4[3]); }
    LAS float* t = tile + kk * 65 + seg;
    t[0] = a.x; t[1] = a.y; t[2] = a.z; t[3] = a.w; t[4] = b.x; t[5] = b.y; t[6] = b.z; t[7] = b.w;
    __syncthreads();
    const int n = tid >> 3, ks = (tid & 7) * 8;
    const LAS float* s = tile + ks * 65 + n;
    u32x4 w; w.x = pk2(s[0], s[65]); w.y = pk2(s[2 * 65], s[3 * 65]); w.z = pk2(s[4 * 65], s[5 * 65]); w.w = pk2(s[6 * 65], s[7 * 65]);
    *(u32x4*)(dst + (size_t)(r0 + n) * lddst + k0 + ks) = w;
    __syncthreads();
}
__device__ __forceinline__ void cvt_tile_lr(const float* __restrict__ win_l, const float* __restrict__ upw_d, int dir, int k0, int c0, bf16_t* __restrict__ dst, int r0, LAS float* tile, int tid) {
    const int kk = tid >> 3, seg = (tid & 7) * 8;
    const float4* wr = (const float4*)(win_l + (size_t)(k0 + kk) * NIN + 4096 + dir * 16);
    const float4 w0 = wr[0], w1 = wr[1], w2 = wr[2], w3 = wr[3];
    const float wv[16] = {w0.x, w0.y, w0.z, w0.w, w1.x, w1.y, w1.z, w1.w, w2.x, w2.y, w2.z, w2.w, w3.x, w3.y, w3.z, w3.w};
    float o[8] = {0.f, 0.f, 0.f, 0.f, 0.f, 0.f, 0.f, 0.f};
#pragma unroll
    for (int r = 0; r < 16; ++r) { const float4* up = (const float4*)(upw_d + (size_t)r * 256 + c0 + seg); const float4 a = up[0], b = up[1];
        o[0] += wv[r] * a.x; o[1] += wv[r] * a.y; o[2] += wv[r] * a.z; o[3] += wv[r] * a.w; o[4] += wv[r] * b.x; o[5] += wv[r] * b.y; o[6] += wv[r] * b.z; o[7] += wv[r] * b.w; }
    LAS float* t = tile + kk * 65 + seg;
#pragma unroll
    for (int j = 0; j < 8; ++j) t[j] = o[j];
    __syncthreads();
    const int n = tid >> 3, ks = (tid & 7) * 8;
    const LAS float* s = tile + ks * 65 + n;
    u32x4 w; w.x = pk2(s[0], s[65]); w.y = pk2(s[2 * 65], s[3 * 65]); w.z = pk2(s[4 * 65], s[5 * 65]); w.w = pk2(s[6 * 65], s[7 * 65]);
    *(u32x4*)(dst + (size_t)(r0 + n) * DM + k0 + ks) = w;
    __syncthreads();
}
__device__ __forceinline__ void convert_phase(LAS unsigned char* lds, const Params& p, int l) {
    LAS float* tile = (LAS float*)lds; int tid_ = threadIdx.x; asm volatile("" : "+v"(tid_)); const int tid = tid_; unsigned char* ws = p.ws;
    for (int it = blockIdx.x * NTHR + tid; it < 16384; it += gridDim.x * NTHR) {
        const int lane = it & 63, ks = (it >> 6) & 1, nt = (it >> 7) & 3, mat = (it >> 9) & 1, w = (it >> 10) & 7, dir = it >> 13;
        const float* src = (mat ? p.in[13] : p.in[11]) + (size_t)((l * 2 + dir) * 8 + w) * 4096;
        float v[8];
#pragma unroll
        for (int e = 0; e < 8; ++e) v[e] = src[(ks * 32 + (lane >> 4) * 8 + e) * 64 + nt * 16 + (lane & 15)];
        u32x4 o; o.x = pk2(v[0], v[1]); o.y = pk2(v[2], v[3]); o.z = pk2(v[4], v[5]); o.w = pk2(v[6], v[7]);
        *(u32x4*)((bf16_t*)(ws + WS_RGW) + (size_t)it * 8) = o;
    }
    for (int idx = blockIdx.x; idx < 4928; idx += gridDim.x) {
        int i = idx;
        if (i < 2048) { const int nb = i % 128, kb = i / 128, r0 = nb * 64; const int c0 = (r0 < 4096) ? r0 : r0 + 32;
            cvt_tile(p.in[3] + (size_t)l * DM * NIN, NIN, kb * 64, c0, 64, (bf16_t*)(ws + WS_WIN), DM, r0, tile, tid); continue; }
        i -= 2048;
        if (i < 128) { const int dir = i >> 6, cb = (i >> 4) & 3, kb = i & 15;
            cvt_tile_lr(p.in[3] + (size_t)l * DM * NIN, p.in[6] + (size_t)(l * 2 + dir) * 16 * 256, dir, kb * 64, cb * 64, (bf16_t*)(ws + WS_WIN), 8192 + dir * 256 + cb * 64, tile, tid); continue; }
        i -= 128;
        if (i < 384) { const int b = i / 128, rem = i % 128, nb = rem % 16, kb = rem / 16;
            cvt_tile(p.in[16] + (size_t)(l * 3 + b) * 512 * DM, DM, kb * 64, nb * 64, 64, (bf16_t*)(ws + WS_WB) + (size_t)b * DM * 512, 512, nb * 64, tile, tid); continue; }
        i -= 384;
        if (i < 256) { const int nb = i % 16, kb = i / 16;
            cvt_tile(p.in[17] + (size_t)l * DM * DM, DM, kb * 64, nb * 64, 64, (bf16_t*)(ws + WS_WOUT), DM, nb * 64, tile, tid); continue; }
        i -= 256;
        if (i < 1408) { const int nb = i % 88, kb = i / 88;
            cvt_tile(p.in[19] + (size_t)l * DM * 2 * DFF, 2 * DFF, kb * 64, nb * 64, 64, (bf16_t*)(ws + WS_WUP), DM, nb * 64, tile, tid); continue; }
        i -= 1408;
        { const int nb = i % 16, kb = i / 16;
            cvt_tile(p.in[22] + (size_t)l * DFF * DM, DM, kb * 64, nb * 64, 64, (bf16_t*)(ws + WS_WDN), DFF, nb * 64, tile, tid); }
    }
}

__device__ __forceinline__ void norm_phase(const float* __restrict__ src, float* xcopy, const float* __restrict__ w, bf16_t* hb, int nrows) {
    int tid_ = threadIdx.x; asm volatile("" : "+v"(tid_));
    const int lane = tid_ & 63, wv = blockIdx.x * 8 + (tid_ >> 6), nwv = gridDim.x * 8;
    float4 wv4[4];
#pragma unroll
    for (int j = 0; j < 4; ++j) wv4[j] = ((const float4*)w)[lane + 64 * j];
    for (int row = wv; row < nrows; row += nwv) {
        const float4* pr = (const float4*)(src + (size_t)row * DM); float4 v[4]; float ss = 0.f;
#pragma unroll
        for (int j = 0; j < 4; ++j) { v[j] = pr[lane + 64 * j]; ss += v[j].x * v[j].x + v[j].y * v[j].y + v[j].z * v[j].z + v[j].w * v[j].w; }
        ss = wave_sum(ss); const float rs = rsqrtf(ss * (1.0f / DM) + EPS);
#pragma unroll
        for (int j = 0; j < 4; ++j) { u32x2 o; o.x = pk2(v[j].x * rs * wv4[j].x, v[j].y * rs * wv4[j].y); o.y = pk2(v[j].z * rs * wv4[j].z, v[j].w * rs * wv4[j].w);
            *(u32x2*)(hb + (size_t)row * DM + (lane + 64 * j) * 4) = o;
            if (xcopy) ((float4*)(xcopy + (size_t)row * DM))[lane + 64 * j] = v[j]; }
    }
}
__device__ __forceinline__ void final_norm_phase(float* x, const float* __restrict__ w, int nrows) {
    int tid_ = threadIdx.x; asm volatile("" : "+v"(tid_));
    const int lane = tid_ & 63, wv = blockIdx.x * 8 + (tid_ >> 6), nwv = gridDim.x * 8;
    float4 wv4[4];
#pragma unroll
    for (int j = 0; j < 4; ++j) wv4[j] = ((const float4*)w)[lane + 64 * j];
    for (int row = wv; row < nrows; row += nwv) {
        float4* pr = (float4*)(x + (size_t)row * DM); float4 v[4]; float ss = 0.f;
#pragma unroll
        for (int j = 0; j < 4; ++j) { v[j] = pr[lane + 64 * j]; ss += v[j].x * v[j].x + v[j].y * v[j].y + v[j].z * v[j].z + v[j].w * v[j].w; }
        ss = wave_sum(ss); const float rs = rsqrtf(ss * (1.0f / DM) + EPS);
#pragma unroll
        for (int j = 0; j < 4; ++j) pr[lane + 64 * j] = make_float4(v[j].x * rs * wv4[j].x, v[j].y * rs * wv4[j].y, v[j].z * rs * wv4[j].z, v[j].w * rs * wv4[j].w);
    }
}

__device__ __forceinline__ float row16_sum(float v) {
    v += __builtin_bit_cast(float, __builtin_amdgcn_update_dpp(0, __builtin_bit_cast(int, v), 0x128, 0xf, 0xf, false));
    v += __builtin_bit_cast(float, __builtin_amdgcn_update_dpp(0, __builtin_bit_cast(int, v), 0x124, 0xf, 0xf, false));
    v += __builtin_bit_cast(float, __builtin_amdgcn_update_dpp(0, __builtin_bit_cast(int, v), 0x122, 0xf, 0xf, false));
    v += __builtin_bit_cast(float, __builtin_amdgcn_update_dpp(0, __builtin_bit_cast(int, v), 0x121, 0xf, 0xf, false));
    return v;
}
#define WAVE_LDS_FENCE() asm volatile("" ::: "memory")
#define LDS_BARRIER() do { asm volatile("s_waitcnt lgkmcnt(0)" ::: "memory"); __builtin_amdgcn_s_barrier(); asm volatile("" ::: "memory"); } while (0)
#define MFMA16(a, b, c) __builtin_amdgcn_mfma_f32_16x16x32_bf16((a), (b), (c), 0, 0, 0)
typedef short bf16x4 __attribute__((ext_vector_type(4)));
#define MFMA16K16(a, b, c) __builtin_amdgcn_mfma_f32_16x16x16bf16_1k((a), (b), (c), 0, 0, 0)
constexpr int GC_STRIDE = 17408, GC_KD = 4352, GC_KTT = 8704, GC_VT = 12800, GC_DEC = 16896;
constexpr int GN_STB = 4 * GC_STRIDE, GN_ATT = GN_STB + 8 * 4352, GN_SSQ = GN_ATT + 8 * 512, GN_DSUM = GN_SSQ + 2048, GN_END = GN_DSUM + 2048;
static_assert(GN_END <= 131072, "GLA LDS map fits");

template <bool ISA, bool OUT>
__device__ __forceinline__ void gla_item(LAS unsigned char* lds, const Params& p, const int l, const int item, unsigned long long* tt) {
    constexpr int DK = ISA ? 128 : 64, DKP = 136, NKS = DK / 32, NNT = DK / 16;
    int tid_ = threadIdx.x; asm volatile("" : "+v"(tid_));
    const int tid = tid_, lane = tid & 63, wid = __builtin_amdgcn_readfirstlane(tid >> 6);
    const int s = item >> 6, h = (item >> 4) & 3, sc = item & 15;
    const int rowbase = s * SEQ + sc * LSC;
    const int l15 = lane & 15, lq = lane >> 4, e0 = wid * 16;
    const int ck = wid >> 1, hh = wid & 1;
    const bool prepqk = ISA || hh == 0;
    const int d = ISA ? hh * 64 + lane : lane, ev = hh * 64 + lane;
    unsigned char* ws = p.ws;
    const bf16_t* proj = (const bf16_t*)(ws + WS_PROJ);
    LAS bf16_t* STB = (LAS bf16_t*)(lds + GN_STB + wid * 4352); LAS bf16_t* ATT = (LAS bf16_t*)(lds + GN_ATT + wid * 512);
    LAS float* SSQ = (LAS float*)(lds + GN_SSQ); LAS float* DSUM = (LAS float*)(lds + GN_DSUM);
    const size_t hoff = (size_t)(h >> 1) * PTILE + (h & 1) * 128;
    const bf16_t* qT = ISA ? proj + hoff : proj + 10 * PTILE + h * 64;
    const bf16_t* vT = proj + (ISA ? 6 : 12) * PTILE + hoff;
    const bf16_t* ogT = proj + (ISA ? 8 : 14) * PTILE + hoff;
    const float qscale = ISA ? 0.08838834764831845f : 0.125f;
    float* ofw = (float*)(ws + (ISA ? WS_H : WS_OFB));
    bf16_t* oout = (bf16_t*)(ws + WS_O) + (ISA ? (size_t)0 : (size_t)MG * 512);
    const float nw = (ISA ? p.in[5] : p.in[8])[l * 128 + e0 + l15];
#pragma unroll 1
    for (int dir = 0; dir < 2; ++dir) {
    const bf16_t* zT = ISA ? proj + (size_t)(2 + 2 * dir) * PTILE + hoff : proj + 11 * PTILE + h * 64;
    const bf16_t* yT = proj + (size_t)(32 + dir) * PTILE + h * 64;
    const int shd = (s * 4 + h) * 2 + dir;
    float* Sg = (float*)(ws + (ISA ? WS_SA : WS_SB)) + ((size_t)shd * NSC + sc) * (size_t)(128 * DK);
    float* Dg = (float*)(ws + (ISA ? WS_DA : WS_DB)) + ((size_t)shd * NSC + sc) * DK;

    float lb = 0.f, upb = 0.f;
    if (ISA) { const int c = h * 128 + d; float x[4], mx = -1e30f;
#pragma unroll
        for (int q = 0; q < 4; ++q) { x[q] = p.in[4][(q * 2 + dir) * 512 + c]; mx = fmaxf(mx, x[q]); }
        float den = 0.f, num = 0.f;
#pragma unroll
        for (int q = 0; q < 4; ++q) { const float ex = __expf(x[q] - mx); den += ex; if (q >= 1 && q <= l) num += ex; }
        lb = num * __builtin_amdgcn_rcpf(den);
    } else upb = p.in[7][(l * 2 + dir) * 256 + h * 64 + d];
    f32x4 ST[NNT];
#pragma unroll
    for (int nt = 0; nt < NNT; ++nt)
#pragma unroll
        for (int r = 0; r < 4; ++r) ST[nt][r] = OUT ? Sg[(size_t)(e0 + lq * 4 + r) * DK + nt * 16 + l15] : 0.f;
    if (OUT) {
#pragma unroll
        for (int nt = 0; nt < NNT; ++nt)
#pragma unroll
            for (int r = 0; r < 4; ++r) STB[(lq * 4 + r) * DKP + nt * 16 + l15] = (bf16_t)f2bf(ST[nt][r]);
    }
    float dsum = 1.f;
    unsigned zr[16];
#define GLA_LOADRAW(SSI) do { const int pos0_ = (SSI) * 64 + ck * 16;     \
        _Pragma("unroll") for (int j = 0; j < 16; ++j) { const size_t ro_ = (size_t)(rowbase + (dir ? (LSC - 1) - (pos0_ + j) : pos0_ + j)) * 256; \
            zr[j] = (unsigned)zT[ro_ + d]; } \
        __builtin_amdgcn_sched_barrier(0); } while (0)
    GLA_LOADRAW(0);
    __syncthreads();

#pragma unroll 1
    for (int ssi = 0; ssi < LSC / 64; ++ssi) {
#ifdef PROBE_STAGES
        unsigned long long ts0 = __builtin_amdgcn_s_memrealtime();
#endif
        { LAS unsigned char* cb = lds + ck * GC_STRIDE;
          LAS bf16_t* QD = (LAS bf16_t*)cb; LAS bf16_t* KD = (LAS bf16_t*)(cb + GC_KD); LAS bf16_t* KTT = (LAS bf16_t*)(cb + GC_KTT); LAS bf16_t* VT = (LAS bf16_t*)(cb + GC_VT); LAS float* DEC = (LAS float*)(cb + GC_DEC);
          unsigned qr[16], vr[16], yr[16];
          { const int pos0_ = ssi * 64 + ck * 16;
#pragma unroll
            for (int j = 0; j < 16; ++j) { const size_t ro_ = (size_t)(rowbase + (dir ? (LSC - 1) - (pos0_ + j) : pos0_ + j)) * 256; qr[j] = OUT ? (unsigned)qT[ro_ + d] : 0u; yr[j] = ISA ? 0u : (unsigned)yT[ro_ + d]; }
            __builtin_amdgcn_sched_barrier(0); }
#define VLOAD() do { const int pv0_ = ssi * 64 + ck * 16; _Pragma("unroll") for (int j = 0; j < 16; ++j) vr[j] = (unsigned)vT[(size_t)(rowbase + (dir ? (LSC - 1) - (pv0_ + j) : pv0_ + j)) * 256 + ev]; __builtin_amdgcn_sched_barrier(0); } while (0)
          VLOAD();
          if (prepqk) {
            float gf[16], kk[16], qs[16], etot = 1.f;
#pragma unroll
            for (int j = 0; j < 16; ++j) { const float a = bf2f(zr[j]);
                if (ISA) { const float sg = sigmoidf_(a); gf[j] = lb + (1.f - lb) * sg; kk[j] = (1.f - lb) * (1.f - sg); const float q = bf2f(qr[j]); qs[j] = q * sigmoidf_(q) * qscale; }
                else { const float y = bf2f(yr[j]) + upb;
                    gf[j] = __builtin_amdgcn_exp2f((fminf(y, 0.f) * 1.4426950408889634f - __builtin_amdgcn_logf(1.f + __expf(-fabsf(y)))) * 0.0625f); kk[j] = a; qs[j] = bf2f(qr[j]) * qscale; }
                etot *= gf[j]; }
            float eb = 1.f, kt[16];
#pragma unroll
            for (int j = 0; j < 16; ++j) { eb *= gf[j];
                const float ebi = __builtin_amdgcn_rcpf(eb);
                if (OUT) { QD[j * DKP + d] = (bf16_t)f2bf(qs[j] * eb); KD[j * DKP + d] = (bf16_t)f2bf(kk[j] * ebi); }
                kt[j] = kk[j] * (etot * ebi); }
            u32x4 w0, w1; w0.x = pk2(kt[0], kt[1]); w0.y = pk2(kt[2], kt[3]); w0.z = pk2(kt[4], kt[5]); w0.w = pk2(kt[6], kt[7]);
            w1.x = pk2(kt[8], kt[9]); w1.y = pk2(kt[10], kt[11]); w1.z = pk2(kt[12], kt[13]); w1.w = pk2(kt[14], kt[15]);
            *(LAS u32x4*)(KTT + d * 16) = w0; *(LAS u32x4*)(KTT + d * 16 + 8) = w1;
            DEC[d] = etot; dsum *= etot;
          }
          u32x4 v0, v1; v0.x = vr[0] | (vr[1] << 16); v0.y = vr[2] | (vr[3] << 16); v0.z = vr[4] | (vr[5] << 16); v0.w = vr[6] | (vr[7] << 16);
          v1.x = vr[8] | (vr[9] << 16); v1.y = vr[10] | (vr[11] << 16); v1.z = vr[12] | (vr[13] << 16); v1.w = vr[14] | (vr[15] << 16);
          *(LAS u32x4*)(VT + ev * 16) = v0; *(LAS u32x4*)(VT + ev * 16 + 8) = v1; }
#ifdef PROBE_STAGES
        { const unsigned long long t1 = __builtin_amdgcn_s_memrealtime(); tt[0] += t1 - ts0; ts0 = t1; }
#endif
        LDS_BARRIER();
#ifdef PROBE_STAGES
        { const unsigned long long t1 = __builtin_amdgcn_s_memrealtime(); tt[1] += t1 - ts0; ts0 = t1; }
#endif
        f32x4 ofv[4], os[4];
        if (OUT && dir == 1) {
#pragma unroll
            for (int kq = 0; kq < 4; ++kq)
#pragma unroll
                for (int r = 0; r < 4; ++r) { const size_t row = (size_t)(rowbase + (LSC - 1) - (ssi * 64 + kq * 16 + lq * 4 + r));
                    ofv[kq][r] = ofw[row * 512 + h * 128 + e0 + l15]; }
        }
        if (ssi < LSC / 64 - 1) GLA_LOADRAW(ssi + 1);
#pragma unroll
        for (int kq = 0; kq < 4; ++kq) {
            const int pos0 = ssi * 64 + kq * 16;
            LAS unsigned char* cb = lds + kq * GC_STRIDE;
            const LAS bf16_t* QD = (const LAS bf16_t*)cb; const LAS bf16_t* KD = (const LAS bf16_t*)(cb + GC_KD); const LAS bf16_t* KTT = (const LAS bf16_t*)(cb + GC_KTT);
            const LAS bf16_t* VT = (const LAS bf16_t*)(cb + GC_VT); const LAS float* DEC = (const LAS float*)(cb + GC_DEC);
            bf16x8 aq[NKS];
            const bf16x4 vt = *(const LAS bf16x4*)(VT + (e0 + l15) * 16 + lq * 4);
            f32x4 o = {0.f, 0.f, 0.f, 0.f};
            if (OUT) {
                f32x4 att = {0.f, 0.f, 0.f, 0.f};
#pragma unroll
                for (int ks = 0; ks < NKS; ++ks) { aq[ks] = *(const LAS bf16x8*)(QD + l15 * DKP + ks * 32 + lq * 8);
                    const bf16x8 bk = *(const LAS bf16x8*)(KD + l15 * DKP + ks * 32 + lq * 8); att = MFMA16(aq[ks], bk, att); }
#pragma unroll
                for (int r = 0; r < 4; ++r) { const int i = lq * 4 + r; const bool keep = l15 <= i; ATT[i * 16 + l15] = keep ? (bf16_t)f2bf(att[r]) : (bf16_t)0; }
                WAVE_LDS_FENCE();
                const bf16x4 aatt = *(const LAS bf16x4*)(ATT + l15 * 16 + lq * 4);
                __builtin_amdgcn_s_setprio(1);
                o = MFMA16K16(aatt, vt, o);
#pragma unroll
                for (int ks = 0; ks < NKS; ++ks) { const bf16x8 bst = *(const LAS bf16x8*)(STB + l15 * DKP + ks * 32 + lq * 8); o = MFMA16(aq[ks], bst, o); }
            }
#pragma unroll
            for (int nt = 0; nt < NNT; ++nt) { const bf16x4 bkt = *(const LAS bf16x4*)(KTT + (nt * 16 + l15) * 16 + lq * 4);
                if (!OUT && nt == 0) __builtin_amdgcn_s_setprio(1);
                const float dec = DEC[nt * 16 + l15]; ST[nt] = MFMA16K16(vt, bkt, ST[nt] * dec); }
            __builtin_amdgcn_s_setprio(0);
            if (OUT) {
                WAVE_LDS_FENCE();
#pragma unroll
                for (int nt = 0; nt < NNT; ++nt)
#pragma unroll
                    for (int r = 0; r < 4; ++r) STB[(lq * 4 + r) * DKP + nt * 16 + l15] = (bf16_t)f2bf(ST[nt][r]);
                if (dir == 0) {
#pragma unroll
                    for (int r = 0; r < 4; ++r) ofw[(size_t)(rowbase + pos0 + lq * 4 + r) * 512 + h * 128 + e0 + l15] = o[r];
                } else {
                    os[kq] = o + ofv[kq];
#pragma unroll
                    for (int r = 0; r < 4; ++r) { float v = os[kq][r] * os[kq][r]; v = row16_sum(v);
                        if (l15 == 0) SSQ[(kq * 16 + lq * 4 + r) * 8 + wid] = v; }
                }
            }
        }
        unsigned ogv[4][4];
        if (OUT && dir == 1) {
#pragma unroll
            for (int kq = 0; kq < 4; ++kq)
#pragma unroll
                for (int r = 0; r < 4; ++r) ogv[kq][r] = ogT[(size_t)(rowbase + (LSC - 1) - (ssi * 64 + kq * 16 + lq * 4 + r)) * 256 + e0 + l15];
            __builtin_amdgcn_sched_barrier(0);
        }
#ifdef PROBE_STAGES
        { const unsigned long long t1 = __builtin_amdgcn_s_memrealtime(); tt[2] += t1 - ts0; ts0 = t1; }
#endif
        LDS_BARRIER();
#ifdef PROBE_STAGES
        { const unsigned long long t1 = __builtin_amdgcn_s_memrealtime(); tt[3] += t1 - ts0; ts0 = t1; }
#endif
        if (OUT && dir == 1) {
#pragma unroll
            for (int kq = 0; kq < 4; ++kq)
#pragma unroll
                for (int r = 0; r < 4; ++r) { const int i = lq * 4 + r; const size_t row = (size_t)(rowbase + (LSC - 1) - (ssi * 64 + kq * 16 + i));
                    const f32x4 a = *(const LAS f32x4*)(SSQ + (kq * 16 + i) * 8), b = *(const LAS f32x4*)(SSQ + (kq * 16 + i) * 8 + 4);
                    const float tot = (a[0] + a[1]) + (a[2] + a[3]) + (b[0] + b[1]) + (b[2] + b[3]); const float rs = rsqrtf(tot * (1.0f / 128.0f) + EPS);
                    const float og = bf2f(ogv[kq][r]); const float val = os[kq][r] * rs * nw * og * sigmoidf_(og);
                    oout[row * 512 + h * 128 + e0 + l15] = (bf16_t)f2bf(val); }
        }
    }
#undef GLA_LOADRAW
#undef VLOAD
    if (!OUT) {
#pragma unroll
        for (int nt = 0; nt < NNT; ++nt)
#pragma unroll
            for (int r = 0; r < 4; ++r) Sg[(size_t)(e0 + lq * 4 + r) * DK + nt * 16 + l15] = ST[nt][r];
        if (prepqk) DSUM[ck * 128 + d] = dsum;
        __syncthreads();
        if (tid < DK) Dg[tid] = (DSUM[tid] * DSUM[128 + tid]) * (DSUM[256 + tid] * DSUM[384 + tid]);
    }
    __syncthreads();
    }
}
template <bool OUT>
__device__ __forceinline__ void rglru_item(LAS unsigned char* lds, const Params& p, const int l, const int item) {
    int tid_ = threadIdx.x; asm volatile("" : "+v"(tid_));
    const int tid = tid_, lane = tid & 63, w = __builtin_amdgcn_readfirstlane(tid >> 6);
    const int s = item >> 7, scc = item & 127, tb = scc * LCC;
    const int l15 = lane & 15, lq = lane >> 4, c = 64 * w + lane;
    unsigned char* ws = p.ws;
    const bf16_t* proj = (const bf16_t*)(ws + WS_PROJ);
    LAS bf16_t* XC = (LAS bf16_t*)(lds + w * 15360); LAS float* AS = (LAS float*)(lds + w * 15360 + 9216); LAS bf16_t* US = (LAS bf16_t*)(lds + w * 15360 + 9216 + 4096);
    const bf16_t* xT = proj + (size_t)(16 + (w >> 2)) * PTILE + (w & 3) * 64 + lane;
    const bf16_t* yT = proj + (size_t)(18 + (w >> 2)) * PTILE + (w & 3) * 64 + lane;
    bf16_t* oc = (bf16_t*)(ws + WS_O) + (size_t)2 * MG * 512;
    float* CH = (float*)(ws + WS_CH); float* CP = (float*)(ws + WS_CP);
    const float cw0 = p.in[9][(l * 4 + 0) * 512 + c], cw1 = p.in[9][(l * 4 + 1) * 512 + c], cw2 = p.in[9][(l * 4 + 2) * 512 + c], cw3 = p.in[9][(l * 4 + 3) * 512 + c], cb = p.in[10][l * 512 + c];
    {
        float xin[67];
#pragma unroll
        for (int i = 0; i < 67; ++i) { const int t = tb - 2 + i; const int tc = t < 0 ? 0 : (t >= SEQ ? SEQ - 1 : t); const float xx = bf2f((unsigned)xT[(size_t)(s * SEQ + tc) * 256]); xin[i] = (t == tc) ? xx : 0.f; }
#pragma unroll
        for (int i = 0; i < 64; ++i) XC[i * 72 + lane] = (bf16_t)f2bf(cb + cw0 * xin[i] + cw1 * xin[i + 1] + cw2 * xin[i + 2] + cw3 * xin[i + 3]);
    }
#pragma unroll 1
    for (int dir = 0; dir < 2; ++dir) {
        bf16x8 wfa[4][2], wfx[4][2]; float ba[4], bx[4], sp[4];
        { const bf16_t* rgw = (const bf16_t*)(ws + WS_RGW);
#pragma unroll
            for (int nt = 0; nt < 4; ++nt) {
#pragma unroll
                for (int ks = 0; ks < 2; ++ks) { wfa[nt][ks] = *(const bf16x8*)(rgw + (size_t)((((dir * 8 + w) * 2 + 0) * 4 + nt) * 2 + ks) * 512 + lane * 8);
                    wfx[nt][ks] = *(const bf16x8*)(rgw + (size_t)((((dir * 8 + w) * 2 + 1) * 4 + nt) * 2 + ks) * 512 + lane * 8); }
                const int cj = (l * 2 + dir) * 512 + 64 * w + nt * 16 + l15;
                ba[nt] = p.in[12][cj]; bx[nt] = p.in[14][cj]; const float lam = p.in[15][cj];
                sp[nt] = fmaxf(-lam, 0.f) + __logf(1.f + __expf(-fabsf(lam)));
            } }
        const size_t cidx = ((size_t)(s * NCC + scc) * 2 + dir) * 512 + c;
        float hst = OUT ? CH[cidx] : 0.f, pprod = 1.f;
#pragma unroll 1
        for (int sbi = 0; sbi < 4; ++sbi) {
            const int sb = dir ? 3 - sbi : sbi, t0 = tb + 16 * sb;
            LAS bf16_t* XCS = XC + (t0 - tb) * 72;
            unsigned hv[16], yv[16];
            if (OUT && dir == 1) {
#pragma unroll
                for (int i = 0; i < 16; ++i) { const size_t row = (size_t)(s * SEQ + t0 + i); hv[i] = (unsigned)oc[row * 512 + c]; yv[i] = (unsigned)yT[row * 256]; }
                __builtin_amdgcn_sched_barrier(0);
            }
            WAVE_LDS_FENCE();
            f32x4 accr[4], acci[4];
            const bf16x8 af0 = *(const LAS bf16x8*)(XCS + l15 * 72 + lq * 8), af1 = *(const LAS bf16x8*)(XCS + l15 * 72 + 32 + lq * 8);
            __builtin_amdgcn_s_setprio(1);
#pragma unroll
            for (int nt = 0; nt < 4; ++nt) { f32x4 z = {0.f, 0.f, 0.f, 0.f};
                accr[nt] = MFMA16(af0, wfa[nt][0], z); accr[nt] = MFMA16(af1, wfa[nt][1], accr[nt]);
                acci[nt] = MFMA16(af0, wfx[nt][0], z); acci[nt] = MFMA16(af1, wfx[nt][1], acci[nt]); }
            __builtin_amdgcn_s_setprio(0);
#pragma unroll
            for (int nt = 0; nt < 4; ++nt)
#pragma unroll
                for (int r = 0; r < 4; ++r) { const int t = lq * 4 + r, jj = nt * 16 + l15;
                    const float rr = sigmoidf_(accr[nt][r] + ba[nt]), ii = sigmoidf_(acci[nt][r] + bx[nt]);
                    const float la = -8.0f * rr * sp[nt]; const float a = __expf(la); const float mult = __builtin_amdgcn_sqrtf(fmaxf(fmaf(-a, a, 1.0f), 0.f));
                    AS[t * 64 + jj] = a; US[t * 64 + jj] = (bf16_t)f2bf(mult * ii * bf2f((unsigned)XCS[t * 72 + jj])); }
            WAVE_LDS_FENCE();
            if (dir == 0) {
#pragma unroll
                for (int i = 0; i < 16; ++i) { const float a = AS[i * 64 + lane], u = bf2f((unsigned)US[i * 64 + lane]); hst = a * hst + u; pprod *= a;
                    if (OUT) oc[(size_t)(s * SEQ + t0 + i) * 512 + c] = (bf16_t)f2bf(hst); }
            } else {
#pragma unroll
                for (int i2 = 0; i2 < 16; ++i2) { const int i = 15 - i2; const float a = AS[i * 64 + lane], u = bf2f((unsigned)US[i * 64 + lane]); hst = a * hst + u; pprod *= a;
                    if (OUT) oc[(size_t)(s * SEQ + t0 + i) * 512 + c] = (bf16_t)f2bf((bf2f(hv[i]) + hst) * gelu_tanh(bf2f(yv[i]))); }
            }
            WAVE_LDS_FENCE();
        }
        if (!OUT) { CH[cidx] = hst; CP[cidx] = pprod; }
    }
}

__device__ __forceinline__ void scan_phase(const Params& p) {
    unsigned char* ws = p.ws;
    int tid_ = threadIdx.x; asm volatile("" : "+v"(tid_));
    const int gtid = blockIdx.x * NTHR + tid_, nthr = gridDim.x * NTHR;
    constexpr int NA = GS * 4 * 2 * 128 * 128, NB = GS * 4 * 2 * 128 * 64;
    for (int idx = gtid; idx < NA + NB; idx += nthr) {
        const bool isa = idx < NA; const int i = isa ? idx : idx - NA; const int per = isa ? 16384 : 8192, dk = isa ? 128 : 64;
        const int shd = i / per, ed = i - shd * per, d = ed & (dk - 1), dir = shd & 1;
        float* S = (float*)(ws + (isa ? WS_SA : WS_SB)) + (size_t)shd * NSC * per + ed;
        const float* D = (const float*)(ws + (isa ? WS_DA : WS_DB)) + (size_t)shd * NSC * dk + d;
        float cur = 0.f;
        { float tmp[NSC], dd[NSC];
#pragma unroll
            for (int k = 0; k < NSC; ++k) { const int sc = dir ? NSC - 1 - k : k; tmp[k] = S[(size_t)sc * per]; dd[k] = D[(size_t)sc * dk]; }
#pragma unroll
            for (int k = 0; k < NSC; ++k) { const int sc = dir ? NSC - 1 - k : k; S[(size_t)sc * per] = cur; cur = cur * dd[k] + tmp[k]; }
        }
    }
    if (gtid < GS * 2 * 512) {
        const int s = gtid >> 10, dir = (gtid >> 9) & 1, c = gtid & 511;
        float* CH = (float*)(ws + WS_CH); const float* CP = (const float*)(ws + WS_CP);
        float cur = 0.f;
#pragma unroll 1
        for (int q = 0; q < NCC; q += 32) {
            float tmp[32], dd[32];
#pragma unroll
            for (int k = 0; k < 32; ++k) { const int scc = dir ? NCC - 1 - (q + k) : q + k; const size_t ix = ((size_t)(s * NCC + scc) * 2 + dir) * 512 + c; tmp[k] = CH[ix]; dd[k] = CP[ix]; }
#pragma unroll
            for (int k = 0; k < 32; ++k) { const int scc = dir ? NCC - 1 - (q + k) : q + k; const size_t ix = ((size_t)(s * NCC + scc) * 2 + dir) * 512 + c; CH[ix] = cur; cur = cur * dd[k] + tmp[k]; }
        }
    }
}

__device__ __forceinline__ float bfe(const u32x4& v, int e) { const unsigned wd = (e >> 1) == 0 ? v.x : (e >> 1) == 1 ? v.y : (e >> 1) == 2 ? v.z : v.w; return (e & 1) ? bf2f(wd >> 16) : bf2f(wd & 0xffffu); }
__device__ __forceinline__ void convgelu_phase(const Params& p, const int l) {
    unsigned char* ws = p.ws;
    const bf16_t* __restrict__ u = (const bf16_t*)(ws + WS_PROJ); bf16_t* __restrict__ g = (bf16_t*)(ws + WS_O);
    int tid_ = threadIdx.x; asm volatile("" : "+v"(tid_));
    const int gtid = blockIdx.x * NTHR + tid_, nthr = gridDim.x * NTHR;
    const float* cw = p.in[20] + (size_t)l * 3 * 2 * DFF; const float* cbias = p.in[21] + (size_t)l * 2 * DFF;
    constexpr int NCG = DFF / 8, RUN = 16;
    for (int it = gtid; it < NCG * (MG / RUN); it += nthr) {
        const int cg8 = it % NCG, run = it / NCG, c = cg8 * 8, row0 = run * RUN, t0 = row0 & (SEQ - 1);
        float wg[3][8], wv[3][8], bg[8], bv[8];
#pragma unroll
        for (int j = 0; j < 3; ++j)
#pragma unroll
            for (int e = 0; e < 8; ++e) { wg[j][e] = cw[(size_t)j * 2 * DFF + c + e]; wv[j][e] = cw[(size_t)j * 2 * DFF + DFF + c + e]; }
#pragma unroll
        for (int e = 0; e < 8; ++e) { bg[e] = cbias[c + e]; bv[e] = cbias[DFF + c + e]; }
        const u32x4 z4 = {0, 0, 0, 0};
        u32x4 pg = z4, pv = z4, cg_, cv_;
        { const size_t rp = (size_t)(t0 > 0 ? row0 - 1 : row0) * (2 * DFF); pg = __builtin_nontemporal_load((const u32x4*)(u + rp + c)); pv = __builtin_nontemporal_load((const u32x4*)(u + rp + DFF + c)); if (t0 == 0) { pg = z4; pv = z4; } }
        cg_ = __builtin_nontemporal_load((const u32x4*)(u + (size_t)row0 * (2 * DFF) + c)); cv_ = __builtin_nontemporal_load((const u32x4*)(u + (size_t)row0 * (2 * DFF) + DFF + c));
#pragma unroll 4
        for (int i = 0; i < RUN; ++i) {
            u32x4 ng = z4, nv = z4;
            { const bool has = t0 + i + 1 < SEQ; const size_t rn = (size_t)(has ? row0 + i + 1 : row0 + i) * (2 * DFF); ng = __builtin_nontemporal_load((const u32x4*)(u + rn + c)); nv = __builtin_nontemporal_load((const u32x4*)(u + rn + DFF + c)); if (!has) { ng = z4; nv = z4; } }
            float o[8];
#pragma unroll
            for (int e = 0; e < 8; ++e) { const float a = bg[e] + wg[0][e] * bfe(pg, e) + wg[1][e] * bfe(cg_, e) + wg[2][e] * bfe(ng, e);
                const float b = bv[e] + wv[0][e] * bfe(pv, e) + wv[1][e] * bfe(cv_, e) + wv[2][e] * bfe(nv, e); o[e] = gelu_tanh(a) * b; }
            u32x4 w4; w4.x = pk2(o[0], o[1]); w4.y = pk2(o[2], o[3]); w4.z = pk2(o[4], o[5]); w4.w = pk2(o[6], o[7]);
            *(u32x4*)(g + (size_t)(row0 + i) * DFF + c) = w4;
            pg = cg_; pv = cv_; cg_ = ng; cv_ = nv;
        }
    }
}

#ifndef REP_M1
#define REP_M1 1
#endif
#ifndef REP_M3
#define REP_M3 1
#endif
#ifndef REP_MISC
#define REP_MISC 1
#endif
#ifndef REP_RG
#define REP_RG 1
#endif
#ifndef REP_G1
#define REP_G1 1
#endif
#ifndef REP_G5
#define REP_G5 1
#endif
#define PB_G1 1
#define PB_M1 2
#define PB_M2 3
#define PB_M3 4
#define PB_G3 5
#define PB_G4 6
#define PB_N 7
#define PB_G5 8
#define PB_CONV 9
#define PB_G6 10
#ifndef PROBE_A
#define PROBE_A(c) ((c) == PB_M1 || (c) == PB_M3)
#endif
#ifndef PROBE_B
#define PROBE_B(c) ((c) == PB_G1 || (c) == PB_G3 || (c) == PB_G4 || (c) == PB_G5 || (c) == PB_G6)
#endif
__global__ void __launch_bounds__(NTHR, 2) mega_fwd(Params p) {
    extern __shared__ __attribute__((aligned(16))) unsigned char lds_raw[];
    LAS unsigned char* lds = (LAS unsigned char*)lds_raw;
    cg::grid_group grid = cg::this_grid();
    volatile LAS unsigned* bst = (volatile LAS unsigned*)(lds + 131072);
    if (threadIdx.x < 2) bst[threadIdx.x] = 0u;
    __syncthreads();
    const XcdBarrier bar = xcd_barrier_post((unsigned*)(p.ws + WS_BAR), bst);
    unsigned char* ws = p.ws;
    const int G = gridDim.x, bid = blockIdx.x;
    bf16_t* hbuf = (bf16_t*)(ws + WS_H);
    bf16_t* proj = (bf16_t*)(ws + WS_PROJ);

#pragma unroll 1
    for (int l = 0; l < DEPTH; ++l) {
        convert_phase(lds, p, l);
        if (l == 0) grid.sync(); else xcd_barrier(bar);
#pragma unroll 1
        for (int grp = 0; grp < NGRP; ++grp) {
            float* xg = p.out + (size_t)grp * MG * DM;
#pragma unroll 1
            for (int ph_ = 0; ph_ < 11; ++ph_) {
                int ph = ph_; asm volatile("" : "+s"(ph));
                if (ph == 0) {
                    if (grp > 0) continue;
                    if (l == 0) norm_phase(p.in[0], xg, p.in[2] + l * DM, hbuf, MG);
                    else norm_phase(xg, nullptr, p.in[2] + l * DM, hbuf, MG);
                } else if (ph == 1 || ph == 8) {
                    const bool up = ph == 8; const int N = up ? 2 * DFF : NINP;
                    Gemm g{hbuf, (const bf16_t*)(ws + (up ? WS_WUP : WS_WIN)), MG, N, DM}; pg8::StaticOrder S; S.init(MG, N, G, bid);
                    EpiStoreBf16 E{proj, up ? 2 * DFF : 256, up ? 0 : 1}; pg8::gemm_phase<EpiStoreBf16, pg8::StaticOrder>(lds, g, S, E);
                } else if (ph == 2) {
                    for (int it = bid; it < 256; it += G) { if (it < 128) gla_item<true, false>(lds, p, l, it, nullptr); else gla_item<false, false>(lds, p, l, it - 128, nullptr); rglru_item<false>(lds, p, l, it); __syncthreads(); }
                } else if (ph == 3) {
                    scan_phase(p);
                } else if (ph == 4) {
                    for (int it = bid; it < 256; it += G) { if (it < 128) gla_item<true, true>(lds, p, l, it, nullptr); else gla_item<false, true>(lds, p, l, it - 128, nullptr); rglru_item<true>(lds, p, l, it); __syncthreads(); }
                } else if (ph == 5) {
                    Gemm g{(const bf16_t*)(ws + WS_O), (const bf16_t*)(ws + WS_WB), 3 * MG, 3 * DM, 512}; BranchOrder S{MG / 256, G, bid};
                    EpiGate E{proj, hbuf, MG / 256}; pg8::gemm_phase<EpiGate, BranchOrder>(lds, g, S, E);
                } else if (ph == 6 || ph == 10) {
                    const bool dn = ph == 10;
                    Gemm g{dn ? (const bf16_t*)(ws + WS_O) : (const bf16_t*)hbuf, (const bf16_t*)(ws + (dn ? WS_WDN : WS_WOUT)), MG, DM, dn ? DFF : DM}; pg8::StaticOrder S; S.init(MG, DM, G, bid);
                    EpiResid E{xg}; pg8::gemm_phase<EpiResid, pg8::StaticOrder>(lds, g, S, E);
                    if (dn && grp + 1 < NGRP) {
                        float* xn = p.out + (size_t)(grp + 1) * MG * DM;
                        if (l == 0) norm_phase(p.in[1] + (size_t)grp * MG * DM, xn, p.in[2] + l * DM, hbuf, MG);
                        else norm_phase(xn, nullptr, p.in[2] + l * DM, hbuf, MG); }
                } else if (ph == 7) {
                    norm_phase(xg, nullptr, p.in[18] + l * DM, hbuf, MG);
                } else {
                    convgelu_phase(p, l);
                }
                xcd_barrier(bar);
            }
        }
    }
    final_norm_phase(p.out, p.in[23], NSEQ * SEQ);
}

extern "C" void kernel_launch(void* const* d_in, const int* in_sizes, int n_in, void* d_out, int out_size, void* d_ws, size_t ws_size, hipStream_t stream) {
    static int grid = 0;
    if (grid == 0) {
        if (n_in != 24 || ws_size < WS_END) { fprintf(stderr, "kernel_launch: need 24 inputs and %zu bytes of workspace (got %d, %zu)\n", (size_t)WS_END, n_in, ws_size); grid = -1; return; }
        int dev = 0, cus = 0, per_cu = 0;
        hipGetDevice(&dev); hipDeviceGetAttribute(&cus, hipDeviceAttributeMultiprocessorCount, dev);
        hipFuncSetAttribute((const void*)mega_fwd, hipFuncAttributeMaxDynamicSharedMemorySize, LDS_BYTES);
        hipOccupancyMaxActiveBlocksPerMultiprocessor(&per_cu, (const void*)mega_fwd, NTHR, LDS_BYTES);
        if (per_cu < 1) { fprintf(stderr, "kernel_launch: occupancy query says 0 blocks per CU\n"); per_cu = 1; }
        grid = cus;
        (void)hipGetLastError();
    }
    if (grid < 0) return;
    if (hipMemsetAsync((char*)d_ws + WS_BAR, 0, XCD_BAR_WORDS * 4, stream) != hipSuccess) { fprintf(stderr, "kernel_launch: memset of the barrier words failed\n"); return; }
    Params p{};
    for (int i = 0; i < 24; ++i) p.in[i] = (const float*)d_in[i];
    p.out = (float*)d_out; p.ws = (unsigned char*)d_ws;
    void* args[] = {&p};
    hipError_t e = hipLaunchCooperativeKernel((const void*)mega_fwd, dim3(grid), dim3(NTHR), args, LDS_BYTES, stream);
    if (e != hipSuccess) fprintf(stderr, "cooperative launch failed: %s (grid %d)\n", hipGetErrorString(e), grid);
}
```
